# Optimizing an MI355X kernel written in HIP

```python
import math
import jax, jax.numpy as jnp
from jax import lax
import numpy as np


D_MODEL = 2048
BATCH = 4
SEQ = 8192
DEPTH = 1

MLA_HEADS = 8
MLA_NOPE_DIM = 128
MLA_ROPE_DIM = 64
MLA_QK_DIM = MLA_NOPE_DIM + MLA_ROPE_DIM
MLA_V_DIM = 128
MLA_Q_LORA = 512
MLA_KV_LORA = 256
MLA_WIDTH = MLA_HEADS * MLA_V_DIM
GDN_HEADS = 8
GDN_K_DIM = 128
GDN_V_DIM = 128
GDN_WIDTH = GDN_HEADS * GDN_V_DIM
GDN_QKV = 2 * GDN_HEADS * GDN_K_DIM + GDN_WIDTH
CONV_WIDTH = 4
CHUNK = 64
D_MIX = MLA_WIDTH + GDN_WIDTH
ROPE_THETA = 10000.0
NORM_EPS = 1e-6
Q_BLOCK = 128
SPLIT_SIZES = (MLA_Q_LORA, MLA_KV_LORA, MLA_ROPE_DIM, MLA_WIDTH,
               GDN_HEADS * GDN_K_DIM, GDN_HEADS * GDN_K_DIM, GDN_WIDTH,
               GDN_HEADS, GDN_HEADS, GDN_WIDTH)
IN_COLS = sum(SPLIT_SIZES)

kernel_name = 'hymba_mla_gdn_gated_hybrid'


def rms_norm(x, gain):
    xf = x.astype(jnp.float32)
    y = xf * lax.rsqrt(jnp.mean(xf * xf, axis=-1, keepdims=True) + NORM_EPS)
    return (y * gain.astype(jnp.float32)).astype(x.dtype)


def l2_norm(x):
    xf = x.astype(jnp.float32)
    return xf * lax.rsqrt(jnp.sum(xf * xf, axis=-1, keepdims=True) + NORM_EPS)


def rope(x, positions):
    half = x.shape[-1] // 2
    inv_freq = jnp.power(ROPE_THETA, -jnp.arange(half, dtype=jnp.float32) / half)
    ang = positions.astype(jnp.float32)[..., None] * inv_freq
    cos = jnp.cos(ang)[:, :, None, :]
    sin = jnp.sin(ang)[:, :, None, :]
    xf = x.astype(jnp.float32)
    x1, x2 = xf[..., :half], xf[..., half:]
    return jnp.concatenate([x1 * cos - x2 * sin, x2 * cos + x1 * sin], axis=-1).astype(x.dtype)


def mla_branch(cq, ckv, k_rope, positions, q_a_gain, kv_a_gain, w_uq, w_ukv, q_gain, k_gain):
    B, S, _ = cq.shape
    q = (rms_norm(cq, q_a_gain) @ w_uq).reshape(B, S, MLA_HEADS, MLA_QK_DIM)
    kv = (rms_norm(ckv, kv_a_gain) @ w_ukv).reshape(B, S, MLA_HEADS, MLA_NOPE_DIM + MLA_V_DIM)
    k_nope, v = kv[..., :MLA_NOPE_DIM], kv[..., MLA_NOPE_DIM:]
    k_shared = jnp.broadcast_to(k_rope[:, :, None, :], (B, S, MLA_HEADS, MLA_ROPE_DIM))
    k = jnp.concatenate([k_nope, k_shared], axis=-1)
    q = rms_norm(q, q_gain)
    k = rms_norm(k, k_gain)
    q = jnp.concatenate([q[..., :MLA_NOPE_DIM], rope(q[..., MLA_NOPE_DIM:], positions)], axis=-1)
    k = jnp.concatenate([k[..., :MLA_NOPE_DIM], rope(k[..., MLA_NOPE_DIM:], positions)], axis=-1)
    q = q.transpose(0, 2, 1, 3)
    k = k.transpose(0, 2, 1, 3)
    v = v.transpose(0, 2, 1, 3)
    scale = MLA_QK_DIM ** -0.5
    key_idx = jnp.arange(S)

    def block(i):
        start = i * Q_BLOCK
        qb = lax.dynamic_slice_in_dim(q, start, Q_BLOCK, axis=2)
        s = jnp.einsum('bhqd,bhkd->bhqk', qb, k, preferred_element_type=jnp.float32) * scale
        q_idx = start + jnp.arange(Q_BLOCK)
        s = jnp.where(key_idx[None, :] <= q_idx[:, None], s, -jnp.inf)
        p = jax.nn.softmax(s, axis=-1).astype(v.dtype)
        return jnp.einsum('bhqk,bhkd->bqhd', p, v)

    o = lax.map(block, jnp.arange(S // Q_BLOCK))
    return o.transpose(1, 0, 2, 3, 4).reshape(B, S, MLA_WIDTH)


def causal_conv_silu(x, w):
    S = x.shape[1]
    xp = jnp.pad(x, ((0, 0), (CONV_WIDTH - 1, 0), (0, 0)))
    y = xp[:, 0:S, :] * w[0]
    for j in range(1, CONV_WIDTH):
        y = y + xp[:, j:j + S, :] * w[j]
    return jax.nn.silu(y)


def chunked_gated_delta(q, k, v, g, beta):
    B, S, H, Dk = q.shape
    Dv = v.shape[-1]
    N = S // CHUNK

    def to_chunks(t):
        return t.reshape(B, N, CHUNK, H, t.shape[-1]).transpose(0, 3, 1, 2, 4)

    q, k, v = to_chunks(q), to_chunks(k), to_chunks(v)
    g = g.reshape(B, N, CHUNK, H).transpose(0, 3, 1, 2)
    beta = beta.reshape(B, N, CHUNK, H).transpose(0, 3, 1, 2)
    gc = jnp.cumsum(g, axis=-1)
    idx = jnp.arange(CHUNK)
    lower_incl = idx[:, None] >= idx[None, :]
    strict = idx[:, None] > idx[None, :]
    diff = gc[..., :, None] - gc[..., None, :]
    decay = jnp.where(lower_incl, jnp.exp(jnp.where(lower_incl, diff, 0.0)), 0.0)
    k_beta = k * beta[..., None]
    v_beta = v * beta[..., None]
    L = jnp.where(strict, jnp.einsum('bhncd,bhnjd->bhncj', k_beta, k) * decay, 0.0)
    eye = jnp.eye(CHUNK, dtype=jnp.float32)
    rhs = jnp.concatenate([v_beta, k_beta * jnp.exp(gc)[..., None]], axis=-1)
    sol = lax.linalg.triangular_solve(eye + L, rhs, left_side=True, lower=True, unit_diagonal=True)
    u, w = sol[..., :Dv], sol[..., Dv:]
    attn_intra = jnp.einsum('bhncd,bhnjd->bhncj', q, k) * decay
    q_dec = q * jnp.exp(gc)[..., None]
    k_dec = k * jnp.exp(gc[..., -1:] - gc)[..., None]
    g_last = jnp.exp(gc[..., -1])

    def mv(t):
        return jnp.moveaxis(t, 2, 0)

    xs = (mv(u), mv(w), mv(q_dec), mv(k_dec), mv(attn_intra), jnp.moveaxis(g_last, 2, 0))

    def step(state, inp):
        u_c, w_c, qd, kd, a_c, gl = inp
        v_new = u_c - jnp.einsum('bhck,bhkv->bhcv', w_c, state)
        o = jnp.einsum('bhck,bhkv->bhcv', qd, state) + jnp.einsum('bhcj,bhjv->bhcv', a_c, v_new)
        state = state * gl[..., None, None] + jnp.einsum('bhck,bhcv->bhkv', kd, v_new)
        return state, o

    state0 = jnp.zeros((B, H, Dk, Dv), jnp.float32)
    _, o = lax.scan(step, state0, xs)
    return o.transpose(1, 0, 3, 2, 4).reshape(B, S, H, Dv)


def gdn_branch(gq, gk, gv, ga, gb, conv_w, a_log, dt_bias, out_gain):
    B, S, _ = gq.shape
    qkv = causal_conv_silu(jnp.concatenate([gq, gk, gv], axis=-1), conv_w)
    hk = GDN_HEADS * GDN_K_DIM
    q = qkv[..., :hk].reshape(B, S, GDN_HEADS, GDN_K_DIM)
    k = qkv[..., hk:2 * hk].reshape(B, S, GDN_HEADS, GDN_K_DIM)
    v = qkv[..., 2 * hk:].reshape(B, S, GDN_HEADS, GDN_V_DIM).astype(jnp.float32)
    q = l2_norm(q) * (GDN_K_DIM ** -0.5)
    k = l2_norm(k)
    g = -jnp.exp(a_log.astype(jnp.float32)) * jax.nn.softplus(ga.astype(jnp.float32) + dt_bias.astype(jnp.float32))
    beta = jax.nn.sigmoid(gb.astype(jnp.float32))
    o = chunked_gated_delta(q, k, v, g, beta)
    o = rms_norm(o, out_gain).astype(gq.dtype)
    return o.reshape(B, S, GDN_WIDTH)


def setup_inputs(seed: int = 0) -> dict:
    key = jax.random.key(seed)
    ks = jax.random.split(key, 16)
    f32 = jnp.float32

    def dense(k, shape, fan_in):
        return jax.random.normal(k, shape, f32) * fan_in ** -0.5

    def gain(k, shape):
        return 1.0 + 0.02 * jax.random.normal(k, shape, f32)

    x = jax.random.normal(ks[0], (BATCH, SEQ, D_MODEL), f32)
    positions = (jax.random.randint(ks[1], (BATCH, 1), 0, 1024, jnp.int32)
                 + jnp.arange(SEQ, dtype=jnp.int32)[None, :])
    dt = jnp.exp(jax.random.uniform(ks[11], (DEPTH, GDN_HEADS), f32,
                                    minval=math.log(1e-3), maxval=math.log(1e-1)))
    dt_bias = dt + jnp.log(-jnp.expm1(-dt))
    a_log = jnp.log(jax.random.uniform(ks[12], (DEPTH, GDN_HEADS), f32, minval=1.0, maxval=16.0))
    return {
        'x': x,
        'positions': positions,
        'norm_gain': gain(ks[2], (DEPTH, D_MODEL)),
        'w_in': dense(ks[3], (DEPTH, D_MODEL, IN_COLS), D_MODEL),
        'mla_q_a_gain': gain(ks[4], (DEPTH, MLA_Q_LORA)),
        'mla_kv_a_gain': gain(ks[5], (DEPTH, MLA_KV_LORA)),
        'w_uq': dense(ks[6], (DEPTH, MLA_Q_LORA, MLA_HEADS * MLA_QK_DIM), MLA_Q_LORA),
        'w_ukv': dense(ks[7], (DEPTH, MLA_KV_LORA, MLA_HEADS * (MLA_NOPE_DIM + MLA_V_DIM)), MLA_KV_LORA),
        'mla_q_norm_gain': gain(ks[8], (DEPTH, MLA_QK_DIM)),
        'mla_k_norm_gain': gain(ks[9], (DEPTH, MLA_QK_DIM)),
        'gdn_conv_w': dense(ks[10], (DEPTH, CONV_WIDTH, GDN_QKV), CONV_WIDTH),
        'gdn_a_log': a_log,
        'gdn_dt_bias': dt_bias,
        'gdn_out_norm_gain': gain(ks[13], (DEPTH, GDN_V_DIM)),
        'w_out': dense(ks[14], (DEPTH, D_MIX, D_MODEL), D_MIX),
    }


def reference(x, positions, norm_gain, w_in, mla_q_a_gain, mla_kv_a_gain, w_uq, w_ukv,
              mla_q_norm_gain, mla_k_norm_gain, gdn_conv_w, gdn_a_log, gdn_dt_bias,
              gdn_out_norm_gain, w_out):
    B, S, _ = x.shape
    split_idx = np.cumsum(SPLIT_SIZES)[:-1].tolist()
    h = x
    for layer in range(DEPTH):
        xn = rms_norm(h, norm_gain[layer])
        proj = xn @ w_in[layer]
        cq, ckv, k_rope, mla_gate, gq, gk, gv, ga, gb, gdn_gate = jnp.split(proj, split_idx, axis=-1)
        o_mla = mla_branch(cq, ckv, k_rope, positions, mla_q_a_gain[layer], mla_kv_a_gain[layer],
                           w_uq[layer], w_ukv[layer], mla_q_norm_gain[layer], mla_k_norm_gain[layer])
        o_mla = o_mla * jax.nn.silu(mla_gate)
        o_gdn = gdn_branch(gq, gk, gv, ga, gb, gdn_conv_w[layer], gdn_a_log[layer],
                           gdn_dt_bias[layer], gdn_out_norm_gain[layer])
        o_gdn = o_gdn * jax.nn.silu(gdn_gate)
        mixed = jnp.concatenate([o_mla, o_gdn], axis=-1)
        h = h + mixed @ w_out[layer]
    return h
```

```cpp
#include <hip/hip_runtime.h>
#include <hip/hip_cooperative_groups.h>
#include <cstdio>
#include <cstdint>
namespace cg = cooperative_groups;

#ifndef MULTI_LAUNCH
#define MULTI_LAUNCH 0
#endif

typedef unsigned short bf16_t;
typedef short bf16x8 __attribute__((ext_vector_type(8)));
typedef float f32x16 __attribute__((ext_vector_type(16)));
typedef float f32x4 __attribute__((ext_vector_type(4)));
typedef unsigned u32x4 __attribute__((ext_vector_type(4)));
typedef unsigned u32x2 __attribute__((ext_vector_type(2)));
typedef __bf16 bf2_t __attribute__((ext_vector_type(2)));
typedef float f2_t __attribute__((ext_vector_type(2)));

#define DI __device__ __forceinline__
#define MFMA(a, b, c) __builtin_amdgcn_mfma_f32_32x32x16_bf16((a), (b), (c), 0, 0, 0)

constexpr int T_ = 32768;
constexpr int SEQ_ = 8192;
constexpr int DM = 2048;
constexpr int LDK = 2112;
constexpr int NPAD = 6144;
constexpr int LDPA = 2944;
constexpr int LDPB = 3072;
constexpr int C_KR = 768, C_GAB = 832, C_MG = 896, C_GG = 1920;
constexpr float EPS = 1e-6f;
constexpr float QSCALE = 0.07216878364870323f * 1.4426950408889634f;

constexpr size_t WS_CTRL = 0;
constexpr size_t WS_SSQ = 4096;
constexpr size_t WS_GAB = WS_SSQ + 2 * 131072;
constexpr size_t WS_GLAST = WS_GAB + (size_t)T_ * 16 * 4;
constexpr size_t WS_WIN = WS_GLAST + 16384;
constexpr size_t WS_WUQ = WS_WIN + (size_t)NPAD * LDK * 2;
constexpr size_t WS_WUKV = WS_WUQ + (size_t)1536 * 512 * 2;
constexpr size_t WS_WOUT = WS_WUKV + (size_t)2048 * 256 * 2;
constexpr size_t WS_PA = WS_WOUT + (size_t)2048 * LDK * 2;
constexpr size_t WS_PB = WS_PA + (size_t)T_ * LDPA * 2;
constexpr size_t WS_XN = WS_PB + (size_t)T_ * LDPB * 2;
constexpr size_t WS_Q = WS_XN + (size_t)T_ * LDK * 2;
constexpr size_t WS_K = WS_Q + (size_t)T_ * 8 * 192 * 2;
constexpr size_t WS_VT = WS_K + (size_t)T_ * 8 * 192 * 2;
constexpr size_t WS_QD = WS_VT + (size_t)T_ * 1024 * 2;
constexpr size_t WS_KDT = WS_QD + (size_t)T_ * 1024 * 2;
constexpr size_t WS_A = WS_KDT + (size_t)T_ * 1024 * 2;
constexpr size_t WS_END = WS_A + (size_t)4096 * 4096 * 2;
constexpr size_t WS_MIXED = WS_PB;
constexpr size_t WS_UT = WS_XN;
constexpr size_t WS_W = WS_XN + (size_t)T_ * 1024 * 2;

constexpr int SMEM_MAIN = 73728;
constexpr int HALF_LDS = SMEM_MAIN + 128;
constexpr int SMEM_BYTES = 2 * HALF_LDS + 64;

struct Params {
    const float* x; const int* pos; const float* norm_gain; const float* w_in; const float* q_a_gain; const float* kv_a_gain;
    const float* w_uq; const float* w_ukv; const float* q_gain; const float* k_gain; const float* conv_w; const float* a_log;
    const float* dt_bias; const float* out_gain; const float* w_out; float* out; unsigned char* ws;
    int wave_u;
    int vb, vg;
    int wave8;
};

DI unsigned pk2(float a, float b) { f2_t v = {a, b}; bf2_t r = __builtin_convertvector(v, bf2_t); return __builtin_bit_cast(unsigned, r); }
DI bf16_t f2bf(float a) { return (bf16_t)(pk2(a, 0.f) & 0xffffu); }
DI float bflo(unsigned u) { return __uint_as_float(u << 16); }
DI float bfhi(unsigned u) { return __uint_as_float(u & 0xffff0000u); }
DI float bf2f(bf16_t v) { return __uint_as_float(((unsigned)v) << 16); }
DI int crow(int e, int h) { return (e & 3) + 8 * (e >> 2) + 4 * h; }
DI float wave_sum(float v) {
#pragma unroll
    for (int o = 1; o < 64; o <<= 1) v += __shfl_xor(v, o);
    return v;
}
template <int S> DI bf16x8 pack8(const f32x16& x) {
    u32x4 p;
    p.x = pk2(x[8 * S + 0], x[8 * S + 1]); p.y = pk2(x[8 * S + 2], x[8 * S + 3]);
    p.z = pk2(x[8 * S + 4], x[8 * S + 5]); p.w = pk2(x[8 * S + 6], x[8 * S + 7]);
    return __builtin_bit_cast(bf16x8, p);
}
DI bf16x8 ld_frag_perm(const bf16_t* p) {
    u32x2 lo = *(const u32x2*)p; u32x2 hi = *(const u32x2*)(p + 8);
    u32x4 v = {lo.x, lo.y, hi.x, hi.y};
    return __builtin_bit_cast(bf16x8, v);
}
DI int fresh_tid(const Params& p) { int t = p.wave_u * 64 + (int)__builtin_amdgcn_mbcnt_hi(~0u, __builtin_amdgcn_mbcnt_lo(~0u, 0u)); asm volatile("" : "+v"(t)); return t; }
DI unsigned gb_ld(unsigned* q) { return __hip_atomic_load(q, __ATOMIC_RELAXED, __HIP_MEMORY_SCOPE_AGENT); }
DI unsigned gb_add(unsigned* q, unsigned v) { return __hip_atomic_fetch_add(q, v, __ATOMIC_RELAXED, __HIP_MEMORY_SCOPE_AGENT); }
DI void grid_barrier(const Params& p, unsigned round  ) {
    asm volatile("s_waitcnt vmcnt(0)" ::: "memory");
    __syncthreads();
    if (p.wave8 == 0 && (fresh_tid(p) & 63) == 0) {
        unsigned* bar = (unsigned*)(p.ws + WS_CTRL);
        __builtin_amdgcn_fence(__ATOMIC_RELEASE, "agent");
        asm volatile("s_waitcnt vmcnt(0)" ::: "memory");
        const unsigned g = blockIdx.x & 7, nloc = gridDim.x >> 3;
        const unsigned old = gb_add(bar + 128 + g * 32, 1u);
        if (old + 1u == round * nloc) {
            const unsigned og = gb_add(bar + 512, 1u);
            if (og + 1u == round * 8u) gb_add(bar + 640, 1u);
        }
        while (gb_ld(bar + 640) < round) __builtin_amdgcn_s_sleep(1);
        __builtin_amdgcn_fence(__ATOMIC_ACQUIRE, "agent");
        asm volatile("s_waitcnt vmcnt(0)" ::: "memory");
    }
    __syncthreads();
}
DI float silu_f(float y) { return y / (1.f + __expf(-y)); }
DI void zero_acc(f32x16& a) {
#pragma unroll
    for (int e = 0; e < 16; ++e) a[e] = 0.f;
}

DI int win_src_col(int n) {
    if (n < 832) return n;
    if (n < 848) return 4928 + (n - 832);
    if (n < 896) return -1;
    if (n < 1920) return 832 + (n - 896);
    if (n < 2944) return 4944 + (n - 1920);
    if (n < 6016) return 1856 + (n - 2944);
    return -1;
}
template <int MODE>
DI void transpose_tile(const float* __restrict__ W, int K, int Nsrc, bf16_t* __restrict__ WT, int ldo, const float* __restrict__ gain, int k0, int n0,
                       unsigned char* smem, int tid) {
    bf16_t* t = (bf16_t*)smem;
#pragma unroll 4
    for (int i = 0; i < 16; ++i) {
        const int e = tid + 256 * i, kk = e >> 6, nn = e & 63;
        const int src = MODE == 0 ? win_src_col(n0 + nn) : (n0 + nn);
        float v = src >= 0 ? W[(size_t)(k0 + kk) * Nsrc + src] : 0.f;
        if (gain) v *= gain[k0 + kk];
        t[nn * 66 + kk] = f2bf(v);
    }
    __syncthreads();
#pragma unroll
    for (int i = 0; i < 2; ++i) {
        const int c = tid + 256 * i, nn = c >> 3, kc = c & 7;
        const unsigned* s = (const unsigned*)(t + nn * 66 + kc * 8);
        u32x4 o = {s[0], s[1], s[2], s[3]};
        *(u32x4*)(WT + (size_t)(n0 + nn) * ldo + k0 + kc * 8) = o;
    }
    __syncthreads();
}

DI void phase0(const Params& p, unsigned char* smem) {
    const int tid = fresh_tid(p), b = p.vb, G = p.vg;
    float* ssq = (float*)(p.ws + WS_SSQ);
    for (int i = b * 256 + tid; i < 65536; i += G * 256) ssq[i] = 0.f;
    if (b == 0) { for (int i = tid; i < 1024; i += 256) if (i < 64 || i >= 96) ((unsigned*)(p.ws + WS_CTRL))[i] = 0u; }
    if (b == 1 && tid < 32) ((float*)(p.ws + WS_CTRL + 256))[tid] = powf(10000.f, -(float)tid / 32.f);
    constexpr int T_IN = 32 * 96, T_UQ = 8 * 24, T_UKV = 4 * 32, T_OUT = 32 * 32;
    for (int it = b; it < T_IN + T_UQ + T_UKV + T_OUT; it += G) {
        int r = it; const int tid = fresh_tid(p);
        if (r < T_IN) { transpose_tile<0>(p.w_in, 2048, 5968, (bf16_t*)(p.ws + WS_WIN), LDK, nullptr, (r / 96) * 64, (r % 96) * 64, smem, tid); continue; }
        r -= T_IN;
        if (r < T_UQ) { transpose_tile<1>(p.w_uq, 512, 1536, (bf16_t*)(p.ws + WS_WUQ), 512, p.q_a_gain, (r / 24) * 64, (r % 24) * 64, smem, tid); continue; }
        r -= T_UQ;
        if (r < T_UKV) { transpose_tile<1>(p.w_ukv, 256, 2048, (bf16_t*)(p.ws + WS_WUKV), 256, p.kv_a_gain, (r / 32) * 64, (r % 32) * 64, smem, tid); continue; }
        r -= T_UKV;
        transpose_tile<1>(p.w_out, 2048, 2048, (bf16_t*)(p.ws + WS_WOUT), LDK, nullptr, (r / 32) * 64, (r % 32) * 64, smem, tid);
    }
    const int lane = tid & 63, wave = tid >> 6;
    bf16_t* xn = (bf16_t*)(p.ws + WS_XN);
    for (int row = b * 4 + wave; row < T_; row += G * 8) {
        const int row2 = row + G * 4;
        const f32x4* xr = (const f32x4*)(p.x + (size_t)row * DM);
        const f32x4* xr2 = (const f32x4*)(p.x + (size_t)row2 * DM);
        f32x4 v[8], w[8]; float ss = 0.f, ss2 = 0.f;
#pragma unroll
        for (int i = 0; i < 8; ++i) { v[i] = __builtin_nontemporal_load(xr + lane + 64 * i); w[i] = __builtin_nontemporal_load(xr2 + lane + 64 * i); }
#pragma unroll
        for (int i = 0; i < 8; ++i) {
            ss += v[i].x * v[i].x + v[i].y * v[i].y + v[i].z * v[i].z + v[i].w * v[i].w;
            ss2 += w[i].x * w[i].x + w[i].y * w[i].y + w[i].z * w[i].z + w[i].w * w[i].w;
        }
        ss = wave_sum(ss); ss2 = wave_sum(ss2);
        const float rs = rsqrtf(ss * (1.f / DM) + EPS), rs2 = rsqrtf(ss2 * (1.f / DM) + EPS);
#pragma unroll
        for (int i = 0; i < 8; ++i) {
            const f32x4 g = ((const f32x4*)p.norm_gain)[lane + 64 * i];
            u32x2 o; o.x = pk2(v[i].x * rs * g.x, v[i].y * rs * g.y); o.y = pk2(v[i].z * rs * g.z, v[i].w * rs * g.w);
            *(u32x2*)(xn + (size_t)row * LDK + (lane + 64 * i) * 4) = o;
            u32x2 o2; o2.x = pk2(w[i].x * rs2 * g.x, w[i].y * rs2 * g.y); o2.y = pk2(w[i].z * rs2 * g.z, w[i].w * rs2 * g.w);
            *(u32x2*)(xn + (size_t)row2 * LDK + (lane + 64 * i) * 4) = o2;
        }
    }
}

template <int BM, int BN, int BK, int WAVES_M, int WAVES_N, int UNSWAP_FROM>
DI void gemm_mainloop(const int tid, const bf16_t* __restrict__ A, int lda, const bf16_t* __restrict__ Bt, int ldb, int K, unsigned char* smem,
                      f32x16 (&acc)[BM / WAVES_M / 32][BN / WAVES_N / 32]) {
    constexpr int WM = BM / WAVES_M / 32, WN = BN / WAVES_N / 32;
    constexpr int LS = BK + 8;
    constexpr int A_ST = BM * LS * 2, B_ST = BN * LS * 2, STAGE = A_ST + B_ST;
    constexpr int CPR = BK / 8, NA = BM * CPR / 256, NB = BN * CPR / 256;
    static_assert(2 * STAGE <= SMEM_MAIN, "LDS");
    const int lane = tid & 63, wave = tid >> 6, r = lane & 31, h = lane >> 5;
    const int wm = wave / WAVES_N, wn = wave % WAVES_N;
    u32x4 ra[NA], rb[NB];
#pragma unroll
    for (int i = 0; i < WM; ++i)
#pragma unroll
        for (int j = 0; j < WN; ++j) zero_acc(acc[i][j]);
    const int nk = K / BK;
#define G_LOAD(kt)                                                                                              \
    {                                                                                                           \
        _Pragma("unroll") for (int i = 0; i < NA; ++i) { const int c = tid + 256 * i, row = c / CPR, kc = c % CPR; \
            ra[i] = *(const u32x4*)(A + (size_t)row * lda + (kt) * BK + kc * 8); }                              \
        _Pragma("unroll") for (int i = 0; i < NB; ++i) { const int c = tid + 256 * i, row = c / CPR, kc = c % CPR; \
            rb[i] = *(const u32x4*)(Bt + (size_t)row * ldb + (kt) * BK + kc * 8); }                             \
    }
#define G_STORE(buf)                                                                                            \
    {                                                                                                           \
        unsigned char* sa_ = smem + (buf) * STAGE; unsigned char* sb_ = sa_ + A_ST;                             \
        _Pragma("unroll") for (int i = 0; i < NA; ++i) { const int c = tid + 256 * i, row = c / CPR, kc = c % CPR; \
            *(u32x4*)(sa_ + (row * LS + kc * 8) * 2) = ra[i]; }                                                 \
        _Pragma("unroll") for (int i = 0; i < NB; ++i) { const int c = tid + 256 * i, row = c / CPR, kc = c % CPR; \
            *(u32x4*)(sb_ + (row * LS + kc * 8) * 2) = rb[i]; }                                                 \
    }
    G_LOAD(0); G_STORE(0); __syncthreads();
    for (int kt = 0; kt < nk; ++kt) {
        const int buf = kt & 1;
        if (kt + 1 < nk) G_LOAD(kt + 1);
        const unsigned char* sa_ = smem + buf * STAGE; const unsigned char* sb_ = sa_ + A_ST;
#pragma unroll
        for (int ks = 0; ks < BK / 16; ++ks) {
            bf16x8 af[WM], bfr[WN];
#pragma unroll
            for (int i = 0; i < WM; ++i) af[i] = *(const bf16x8*)(sa_ + (((wm * WM + i) * 32 + r) * LS + ks * 16 + h * 8) * 2);
#pragma unroll
            for (int j = 0; j < WN; ++j) bfr[j] = *(const bf16x8*)(sb_ + (((wn * WN + j) * 32 + r) * LS + ks * 16 + h * 8) * 2);
#pragma unroll
            for (int i = 0; i < WM; ++i)
#pragma unroll
                for (int j = 0; j < WN; ++j) {
                    if (j < UNSWAP_FROM) acc[i][j] = MFMA(bfr[j], af[i], acc[i][j]);
                    else acc[i][j] = MFMA(af[i], bfr[j], acc[i][j]);
                }
        }
        if (kt + 1 < nk) G_STORE(buf ^ 1);
        __syncthreads();
    }
#undef G_LOAD
#undef G_STORE
}

typedef __attribute__((address_space(3))) unsigned lds_u32;
#define MFMA16(a, b, c) __builtin_amdgcn_mfma_f32_16x16x32_bf16((a), (b), (c), 0, 0, 0)
DI void gemm3_mainloop(const int wave8, const int lane, const bf16_t* __restrict__ A, int lda, const bf16_t* __restrict__ Bt, int ldb, int K,
                       unsigned char* smem, f32x4 (&acc)[8][4]) {
    constexpr int STAGE = 512 * 128, B_OFF = 256 * 128;
    const int fr = lane & 15, fq = lane >> 4, wm = wave8 >> 2, wn = wave8 & 3;
    const int t512 = wave8 * 64 + lane;
#pragma unroll
    for (int i = 0; i < 8; ++i)
#pragma unroll
        for (int j = 0; j < 4; ++j) acc[i][j] = (f32x4){0.f, 0.f, 0.f, 0.f};
    const int nk = K / 64;
    const int srow = t512 >> 3, ssc = (t512 & 7) ^ ((srow >> 1) & 7);
    const bf16_t* ga = A + (size_t)srow * lda + ssc * 8;
    const bf16_t* gb = Bt + (size_t)srow * ldb + ssc * 8;
    unsigned char* sdst = smem + wave8 * 1024;
#define G3_LDA(buf, kt, i) __builtin_amdgcn_global_load_lds((const unsigned*)(ga + (size_t)((i) * 64) * lda + (kt) * 64), (lds_u32*)(sdst + (buf) * STAGE + (i) * 8192), 16, 0, 0)
#define G3_LDB(buf, kt, i) __builtin_amdgcn_global_load_lds((const unsigned*)(gb + (size_t)((i) * 64) * ldb + (kt) * 64), (lds_u32*)(sdst + (buf) * STAGE + B_OFF + (i) * 8192), 16, 0, 0)
    const int sw = (fr >> 1) & 7;
#define G3_HALF(buf, nbuf, kn, hf)                                                                               \
    {                                                                                                            \
        const unsigned char* sa_ = smem + (buf) * STAGE; const unsigned char* sb_ = sa_ + B_OFF;                 \
        const int co = (((hf) * 4 + fq) ^ sw) * 16;                                                              \
        bf16x8 af[8], bfr[4];                                                                                    \
        _Pragma("unroll") for (int j = 0; j < 4; ++j) bfr[j] = *(const bf16x8*)(sb_ + (wn * 64 + j * 16 + fr) * 128 + co); \
        _Pragma("unroll") for (int i = 0; i < 8; ++i) af[i] = *(const bf16x8*)(sa_ + (wm * 128 + i * 16 + fr) * 128 + co); \
        _Pragma("unroll") for (int i = 0; i < 8; ++i) {                                                            \
            _Pragma("unroll") for (int j = 0; j < 4; ++j) acc[i][j] = MFMA16(bfr[j], af[i], acc[i][j]);            \
            if (i < 4) { if ((hf) == 0) { G3_LDA(nbuf, kn, i); } else { G3_LDB(nbuf, kn, i); } }                  \
        }                                                                                                        \
        __builtin_amdgcn_sched_group_barrier(0x100, 12, 0);                                                      \
        _Pragma("unroll") for (int q = 0; q < 4; ++q) { __builtin_amdgcn_sched_group_barrier(0x008, 4, 0); __builtin_amdgcn_sched_group_barrier(0x020, 1, 0); } \
        __builtin_amdgcn_sched_group_barrier(0x008, 16, 0);                                                      \
    }
#define G3_STEP(buf, nbuf, kt)                                                                                   \
    {                                                                                                            \
        const int kn_ = ((kt) + 1 < nk) ? (kt) + 1 : (kt);         \
        G3_HALF(buf, nbuf, kn_, 0); G3_HALF(buf, nbuf, kn_, 1);                                                   \
        asm volatile("s_waitcnt vmcnt(0)" ::: "memory");                                                         \
        __builtin_amdgcn_s_barrier();                                                                            \
    }
    asm volatile("s_waitcnt vmcnt(0)" ::: "memory");
    G3_LDA(0, 0, 0); G3_LDA(0, 0, 1); G3_LDA(0, 0, 2); G3_LDA(0, 0, 3); G3_LDB(0, 0, 0); G3_LDB(0, 0, 1); G3_LDB(0, 0, 2); G3_LDB(0, 0, 3);
    asm volatile("s_waitcnt vmcnt(0)" ::: "memory");
    __builtin_amdgcn_s_barrier();
    for (int kt = 0; kt < nk; kt += 2) { G3_STEP(0, 1, kt); G3_STEP(1, 0, kt + 1); }
#undef G3_STEP
#undef G3_HALF
#undef G3_LDA
#undef G3_LDB
}

template <typename F> DI void for_tiles3(int MT, int NT, F f) {
    const int b = blockIdx.x, G = gridDim.x, xcd = b & 7, slot = b >> 3, slots = G >> 3;
    const int nsn = NT / 4, nsm = MT / 8;
    for (int sidx = xcd; sidx < nsn * nsm; sidx += 8) {
        const int sm = sidx / nsn, sn = sidx % nsn;
        for (int tl = slot; tl < 32; tl += slots) f(sm * 8 + (tl & 7), sn * 4 + (tl >> 3));
    }
}

DI void phase1(const Params& p, unsigned char* smem) {
    const bf16_t* xn = (const bf16_t*)(p.ws + WS_XN);
    const bf16_t* wt = (const bf16_t*)(p.ws + WS_WIN);
    bf16_t* pa = (bf16_t*)(p.ws + WS_PA); bf16_t* pb = (bf16_t*)(p.ws + WS_PB);
    float* ssq = (float*)(p.ws + WS_SSQ); float* gab = (float*)(p.ws + WS_GAB);
    for_tiles3(T_ / 256, NPAD / 256, [&](int mt, int nt) {
        const int lane = fresh_tid(p) & 63, fr = lane & 15, fq = lane >> 4, wm = p.wave8 >> 2, wn = p.wave8 & 3;
        f32x4 acc[8][4];
        gemm3_mainloop(p.wave8, lane, xn + (size_t)mt * 256 * LDK, LDK, wt + (size_t)nt * 256 * LDK, LDK, DM, smem, acc);
        const int c128 = nt * 2 + (wn >> 1);
        if (c128 >= 47) return;
        bf16_t* dst; int ld, c0;
        if (c128 < 23) { dst = pa; ld = LDPA; c0 = c128 * 128; } else { dst = pb; ld = LDPB; c0 = (c128 - 23) * 128; }
#pragma unroll
        for (int i = 0; i < 8; ++i) {
            const int m = mt * 256 + wm * 128 + i * 16 + fr;
            float ss = 0.f;
#pragma unroll
            for (int j = 0; j < 4; ++j) {
                const f32x4 v = acc[i][j];
                ss += v.x * v.x + v.y * v.y + v.z * v.z + v.w * v.w;
                u32x2 o; o.x = pk2(v.x, v.y); o.y = pk2(v.z, v.w);
                *(u32x2*)(dst + (size_t)m * ld + c0 + (wn & 1) * 64 + j * 16 + fq * 4) = o;
            }
            if (c128 < 6) {
                ss += __shfl_xor(ss, 16); ss += __shfl_xor(ss, 32);
                if (fq == 0) atomicAdd(ssq + (c128 < 4 ? 0 : T_) + m, ss);
            }
            if (c128 == 6 && (wn & 1) == 1) *(f32x4*)(gab + (size_t)m * 16 + fq * 4) = acc[i][0];
        }
    });
}

DI void sincos_rev(float ang, float& sn, float& cs) {
    const float c_hi = 0.15915494309189535f, c_lo = -6.0e-9f * 0.0f + (float)(0.15915494309189535 - (double)0.15915494309189535f);
    const float pr = ang * c_hi, er = __builtin_fmaf(ang, c_hi, -pr);
    const float rev = __builtin_amdgcn_fractf(pr) + (er + ang * c_lo);
    sn = __builtin_amdgcn_sinf(rev); cs = __builtin_amdgcn_cosf(rev);
}

DI void q_tile(const Params& p, int mt, int hd, unsigned char* smem) {
    const bf16_t* pa = (const bf16_t*)(p.ws + WS_PA);
    const bf16_t* wt = (const bf16_t*)(p.ws + WS_WUQ);
    const float* ssq = (const float*)(p.ws + WS_SSQ);
    bf16_t* Q = (bf16_t*)(p.ws + WS_Q);
    const int tid = fresh_tid(p), lane = tid & 63, wave = tid >> 6, r = lane & 31, h = lane >> 5;
    f32x16 acc[1][6];
    gemm_mainloop<128, 192, 32, 4, 1, 99>(tid, pa + (size_t)mt * 128 * LDPA, LDPA, wt + (size_t)hd * 192 * 512, 512, 512, smem, acc);
    const int m = mt * 128 + wave * 32 + r;
    const float rq = rsqrtf(ssq[m] * (1.f / 512.f) + EPS);
    float ss = 0.f;
#pragma unroll
    for (int j = 0; j < 6; ++j)
#pragma unroll
        for (int e = 0; e < 16; ++e) { const float v = acc[0][j][e] * rq; acc[0][j][e] = v; ss += v * v; }
    ss += __shfl_xor(ss, 32);
    const float rs = rsqrtf(ss * (1.f / 192.f) + EPS) * QSCALE;
    const int bb = m >> 13, s = m & 8191;
    bf16_t* qrow = Q + ((size_t)(bb * 8 + hd) * SEQ_ + s) * 192;
#pragma unroll
    for (int j = 0; j < 4; ++j)
#pragma unroll
        for (int g = 0; g < 4; ++g) {
            const int n = j * 32 + 8 * g + 4 * h;
            const f32x4 gn = *(const f32x4*)(p.q_gain + n);
            u32x2 o; o.x = pk2(acc[0][j][4 * g] * rs * gn.x, acc[0][j][4 * g + 1] * rs * gn.y);
            o.y = pk2(acc[0][j][4 * g + 2] * rs * gn.z, acc[0][j][4 * g + 3] * rs * gn.w);
            *(u32x2*)(qrow + n) = o;
        }
    const float posf = (float)p.pos[m];
    const float* invf = (const float*)(p.ws + WS_CTRL + 256);
#pragma unroll
    for (int g = 0; g < 4; ++g) {
        float o1[4], o2[4];
#pragma unroll
        for (int jj = 0; jj < 4; ++jj) {
            const int i = 8 * g + 4 * h + jj;
            float sn, cs; sincos_rev(posf * invf[i], sn, cs);
            const float x1 = acc[0][4][4 * g + jj] * rs * p.q_gain[128 + i], x2 = acc[0][5][4 * g + jj] * rs * p.q_gain[160 + i];
            o1[jj] = x1 * cs - x2 * sn; o2[jj] = x2 * cs + x1 * sn;
        }
        u32x2 a; a.x = pk2(o1[0], o1[1]); a.y = pk2(o1[2], o1[3]);
        u32x2 c; c.x = pk2(o2[0], o2[1]); c.y = pk2(o2[2], o2[3]);
        *(u32x2*)(qrow + 128 + 8 * g + 4 * h) = a;
        *(u32x2*)(qrow + 160 + 8 * g + 4 * h) = c;
    }
}

DI void kv_tile(const Params& p, int mt, int hd, unsigned char* smem) {
    const bf16_t* pa = (const bf16_t*)(p.ws + WS_PA);
    const bf16_t* wt = (const bf16_t*)(p.ws + WS_WUKV);
    const float* ssq = (const float*)(p.ws + WS_SSQ) + T_;
    bf16_t* Kb = (bf16_t*)(p.ws + WS_K); bf16_t* Vt = (bf16_t*)(p.ws + WS_VT);
    const int tid = fresh_tid(p), lane = tid & 63, wave = tid >> 6, r = lane & 31, h = lane >> 5;
    f32x16 acc[1][4];
    const int mw = mt * 128 + wave * 32;
    const int bb = mw >> 13, sw = mw & 8191, bh = bb * 8 + hd;
    gemm_mainloop<128, 128, 32, 4, 1, 0>(tid, pa + (size_t)mt * 128 * LDPA + 512, LDPA, wt + (size_t)(hd * 256 + 128) * 256, 256, 256, smem, acc);
#pragma unroll
    for (int g = 0; g < 4; ++g) {
        const f32x4 q4 = *(const f32x4*)(ssq + mw + 8 * g + 4 * h);
        const float r0 = rsqrtf(q4.x * (1.f / 256.f) + EPS), r1 = rsqrtf(q4.y * (1.f / 256.f) + EPS);
        const float r2 = rsqrtf(q4.z * (1.f / 256.f) + EPS), r3 = rsqrtf(q4.w * (1.f / 256.f) + EPS);
#pragma unroll
        for (int j = 0; j < 4; ++j) {
            u32x2 o; o.x = pk2(acc[0][j][4 * g] * r0, acc[0][j][4 * g + 1] * r1); o.y = pk2(acc[0][j][4 * g + 2] * r2, acc[0][j][4 * g + 3] * r3);
            *(u32x2*)(Vt + ((size_t)bh * 128 + j * 32 + r) * SEQ_ + sw + 8 * g + 4 * h) = o;
        }
    }
    gemm_mainloop<128, 128, 32, 4, 1, 99>(tid, pa + (size_t)mt * 128 * LDPA + 512, LDPA, wt + (size_t)(hd * 256) * 256, 256, 256, smem, acc);
    const int m = mw + r, s = sw + r;
    const float rkv = rsqrtf(ssq[m] * (1.f / 256.f) + EPS);
    float ss = 0.f;
#pragma unroll
    for (int j = 0; j < 4; ++j)
#pragma unroll
        for (int e = 0; e < 16; ++e) { const float v = acc[0][j][e] * rkv; acc[0][j][e] = v; ss += v * v; }
    float x1[16], x2[16];
#pragma unroll
    for (int g = 0; g < 4; ++g) {
        const u32x2 a = *(const u32x2*)(pa + (size_t)m * LDPA + C_KR + 8 * g + 4 * h);
        const u32x2 c = *(const u32x2*)(pa + (size_t)m * LDPA + C_KR + 32 + 8 * g + 4 * h);
        x1[4 * g] = bflo(a.x); x1[4 * g + 1] = bfhi(a.x); x1[4 * g + 2] = bflo(a.y); x1[4 * g + 3] = bfhi(a.y);
        x2[4 * g] = bflo(c.x); x2[4 * g + 1] = bfhi(c.x); x2[4 * g + 2] = bflo(c.y); x2[4 * g + 3] = bfhi(c.y);
    }
#pragma unroll
    for (int e = 0; e < 16; ++e) ss += x1[e] * x1[e] + x2[e] * x2[e];
    ss += __shfl_xor(ss, 32);
    const float rs = rsqrtf(ss * (1.f / 192.f) + EPS);
    bf16_t* krow = Kb + ((size_t)bh * SEQ_ + s) * 192;
#pragma unroll
    for (int j = 0; j < 4; ++j)
#pragma unroll
        for (int g = 0; g < 4; ++g) {
            const int n = j * 32 + 8 * g + 4 * h;
            const f32x4 gn = *(const f32x4*)(p.k_gain + n);
            u32x2 o; o.x = pk2(acc[0][j][4 * g] * rs * gn.x, acc[0][j][4 * g + 1] * rs * gn.y);
            o.y = pk2(acc[0][j][4 * g + 2] * rs * gn.z, acc[0][j][4 * g + 3] * rs * gn.w);
            *(u32x2*)(krow + n) = o;
        }
    const float posf = (float)p.pos[m];
    const float* invf = (const float*)(p.ws + WS_CTRL + 256);
#pragma unroll
    for (int g = 0; g < 4; ++g) {
        float o1[4], o2[4];
#pragma unroll
        for (int jj = 0; jj < 4; ++jj) {
            const int i = 8 * g + 4 * h + jj;
            float sn, cs; sincos_rev(posf * invf[i], sn, cs);
            const float y1 = x1[4 * g + jj] * rs * p.k_gain[128 + i], y2 = x2[4 * g + jj] * rs * p.k_gain[160 + i];
            o1[jj] = y1 * cs - y2 * sn; o2[jj] = y2 * cs + y1 * sn;
        }
        u32x2 a; a.x = pk2(o1[0], o1[1]); a.y = pk2(o1[2], o1[3]);
        u32x2 c; c.x = pk2(o2[0], o2[1]); c.y = pk2(o2[2], o2[3]);
        *(u32x2*)(krow + 128 + 8 * g + 4 * h) = a;
        *(u32x2*)(krow + 160 + 8 * g + 4 * h) = c;
    }
}

DI void gdn_prep(const Params& p, int item, unsigned char* smem) {
    const int tid = fresh_tid(p), lane = tid & 63, wave = tid >> 6, r = lane & 31, h = lane >> 5;
    const int bb = item >> 10, hd = (item >> 7) & 7, n = item & 127;
    const int tok0 = bb * SEQ_ + n * 64;
    const bf16_t* pb = (const bf16_t*)(p.ws + WS_PB);
    const float* gab = (const float*)(p.ws + WS_GAB);
    bf16_t* sq = (bf16_t*)smem; bf16_t* sk = sq + 64 * 136; bf16_t* sv = sk + 64 * 136;
    float* sL = (float*)(smem + 52224);
    float* sgc = (float*)(smem + 69632); float* sbeta = sgc + 64; float* segc = sbeta + 64;
    {
        const int dch = lane & 15, sub = lane >> 4, t0 = wave * 16 + sub * 4;
#pragma unroll
        for (int X = 0; X < 3; ++X) {
            const int col = X * 1024 + hd * 128 + dch * 8;
            float xr[7][8];
#pragma unroll
            for (int rr = 0; rr < 7; ++rr) {
                const int t = t0 - 3 + rr;
                u32x4 v = {0u, 0u, 0u, 0u};
                if (n > 0 || t >= 0) v = *(const u32x4*)(pb + (size_t)(tok0 + t) * LDPB + col);
                xr[rr][0] = bflo(v.x); xr[rr][1] = bfhi(v.x); xr[rr][2] = bflo(v.y); xr[rr][3] = bfhi(v.y);
                xr[rr][4] = bflo(v.z); xr[rr][5] = bfhi(v.z); xr[rr][6] = bflo(v.w); xr[rr][7] = bfhi(v.w);
            }
            float y[4][8];
#pragma unroll
            for (int tt = 0; tt < 4; ++tt)
#pragma unroll
                for (int c = 0; c < 8; ++c) y[tt][c] = 0.f;
#pragma unroll
            for (int j = 0; j < 4; ++j) {
                const f32x4 w0 = *(const f32x4*)(p.conv_w + j * 3072 + col), w1 = *(const f32x4*)(p.conv_w + j * 3072 + col + 4);
                const float wv[8] = {w0.x, w0.y, w0.z, w0.w, w1.x, w1.y, w1.z, w1.w};
#pragma unroll
                for (int tt = 0; tt < 4; ++tt)
#pragma unroll
                    for (int c = 0; c < 8; ++c) y[tt][c] += xr[tt + j][c] * wv[c];
            }
#pragma unroll
            for (int tt = 0; tt < 4; ++tt) {
                float ss = 0.f;
#pragma unroll
                for (int c = 0; c < 8; ++c) { y[tt][c] = silu_f(y[tt][c]); ss += y[tt][c] * y[tt][c]; }
                float sc = 1.f;
                if (X < 2) {
                    ss += __shfl_xor(ss, 1); ss += __shfl_xor(ss, 2); ss += __shfl_xor(ss, 4); ss += __shfl_xor(ss, 8);
                    sc = rsqrtf(ss + EPS) * (X == 0 ? 0.08838834764831845f : 1.f);
                }
                u32x4 o; o.x = pk2(y[tt][0] * sc, y[tt][1] * sc); o.y = pk2(y[tt][2] * sc, y[tt][3] * sc);
                o.z = pk2(y[tt][4] * sc, y[tt][5] * sc); o.w = pk2(y[tt][6] * sc, y[tt][7] * sc);
                bf16_t* dstp = (X == 0 ? sq : (X == 1 ? sk : sv)) + (t0 + tt) * 136 + dch * 8;
                *(u32x4*)dstp = o;
            }
        }
    }
    if (wave == 0) {
        const float ga = gab[(size_t)(tok0 + lane) * 16 + hd], gb = gab[(size_t)(tok0 + lane) * 16 + 8 + hd];
        const float xx = ga + p.dt_bias[hd];
        const float sp = xx > 20.f ? xx : log1pf(expf(xx));
        float g = -expf(p.a_log[hd]) * sp;
#pragma unroll
        for (int o = 1; o < 64; o <<= 1) { const float t = __shfl_up(g, o); if (lane >= o) g += t; }
        sgc[lane] = g; segc[lane] = expf(g); sbeta[lane] = 1.f / (1.f + expf(-gb));
    }
    __syncthreads();
    {
        const int ti = wave >> 1, tj = wave & 1;
        f32x16 akk, aqk; zero_acc(akk); zero_acc(aqk);
        if (ti >= tj) {
#pragma unroll
            for (int ks = 0; ks < 8; ++ks) {
                const bf16x8 ak = *(const bf16x8*)(sk + (ti * 32 + r) * 136 + ks * 16 + h * 8);
                const bf16x8 aq = *(const bf16x8*)(sq + (ti * 32 + r) * 136 + ks * 16 + h * 8);
                const bf16x8 bk = *(const bf16x8*)(sk + (tj * 32 + r) * 136 + ks * 16 + h * 8);
                akk = MFMA(ak, bk, akk); aqk = MFMA(aq, bk, aqk);
            }
        }
        bf16_t* ag = (bf16_t*)(p.ws + WS_A) + (size_t)item * 4096;
        const int j = tj * 32 + r; const float gcj = sgc[j];
#pragma unroll
        for (int e = 0; e < 16; ++e) {
            const int c = ti * 32 + crow(e, h);
            const float dec = c >= j ? expf(sgc[c] - gcj) : 0.f;
            sL[c * 68 + j] = c > j ? sbeta[c] * akk[e] * dec : 0.f;
            ag[c * 64 + j] = f2bf(aqk[e] * dec);
        }
    }
    __syncthreads();
    {
        float X[64];
        const bf16_t* src = tid < 128 ? (sv + tid) : (sk + tid - 128);
#pragma unroll
        for (int i = 0; i < 64; ++i) { float a = bf2f(src[i * 136]) * sbeta[i]; if (tid >= 128) a *= segc[i]; X[i] = a; }
#pragma unroll
        for (int i = 1; i < 64; ++i) {
            float a = X[i];
            int dep; asm volatile("v_and_b32 %0, 0, %1" : "=v"(dep) : "v"(X[i - 1]));
            const float* Lr = sL + i * 68 + dep;
            float b0 = 0.f, b1 = 0.f, b2 = 0.f;
#pragma unroll
            for (int j4 = 0; j4 < (i + 3) / 4; ++j4) {
                const f32x4 l = *(const f32x4*)(Lr + 4 * j4);
                if (4 * j4 + 0 < i) a -= l.x * X[4 * j4 + 0];
                if (4 * j4 + 1 < i) b0 -= l.y * X[4 * j4 + 1];
                if (4 * j4 + 2 < i) b1 -= l.z * X[4 * j4 + 2];
                if (4 * j4 + 3 < i) b2 -= l.w * X[4 * j4 + 3];
            }
            X[i] = (a + b0) + (b1 + b2);
        }
        if (tid < 128) {
            bf16_t* ut = (bf16_t*)(p.ws + WS_UT) + (size_t)item * 8192 + tid * 64;
#pragma unroll
            for (int c8 = 0; c8 < 8; ++c8) {
                u32x4 o; o.x = pk2(X[8 * c8], X[8 * c8 + 1]); o.y = pk2(X[8 * c8 + 2], X[8 * c8 + 3]);
                o.z = pk2(X[8 * c8 + 4], X[8 * c8 + 5]); o.w = pk2(X[8 * c8 + 6], X[8 * c8 + 7]);
                *(u32x4*)(ut + c8 * 8) = o;
            }
        } else {
            bf16_t* wg = (bf16_t*)(p.ws + WS_W) + (size_t)item * 8192 + (tid - 128);
#pragma unroll
            for (int i = 0; i < 64; ++i) wg[i * 128] = f2bf(X[i]);
        }
    }
    {
        bf16_t* qd = (bf16_t*)(p.ws + WS_QD) + (size_t)item * 8192;
        const int c = tid >> 2, d0 = (tid & 3) * 32; const float eg = segc[c];
#pragma unroll
        for (int q4 = 0; q4 < 4; ++q4) {
            const u32x4 v = *(const u32x4*)(sq + c * 136 + d0 + q4 * 8);
            u32x4 o; o.x = pk2(bflo(v.x) * eg, bfhi(v.x) * eg); o.y = pk2(bflo(v.y) * eg, bfhi(v.y) * eg);
            o.z = pk2(bflo(v.z) * eg, bfhi(v.z) * eg); o.w = pk2(bflo(v.w) * eg, bfhi(v.w) * eg);
            *(u32x4*)(qd + c * 128 + d0 + q4 * 8) = o;
        }
        bf16_t* kdt = (bf16_t*)(p.ws + WS_KDT) + (size_t)item * 8192;
        const int d = tid & 127, ch = tid >> 7; const float gl = sgc[63];
#pragma unroll
        for (int c8 = 0; c8 < 4; ++c8) {
            float v[8];
#pragma unroll
            for (int e = 0; e < 8; ++e) { const int cc = ch * 32 + c8 * 8 + e; v[e] = bf2f(sk[cc * 136 + d]) * expf(gl - sgc[cc]); }
            u32x4 o; o.x = pk2(v[0], v[1]); o.y = pk2(v[2], v[3]); o.z = pk2(v[4], v[5]); o.w = pk2(v[6], v[7]);
            *(u32x4*)(kdt + d * 64 + ch * 32 + c8 * 8) = o;
        }
        if (tid == 0) ((float*)(p.ws + WS_GLAST))[item] = expf(gl);
    }
    __syncthreads();
}

DI void phase2(const Params& p, unsigned char* smem) {
    for (int it = p.vb; it < 8192; it += p.vg) {
        if (it < 4096) gdn_prep(p, it, smem);
        else if (it < 6144) { const int r = it - 4096; q_tile(p, r >> 3, r & 7, smem); }
        else { const int r = it - 6144; kv_tile(p, r >> 3, r & 7, smem); }
    }
}

DI void scan_item(const Params& p, int bh, unsigned char* smem) {
    const int tid = fresh_tid(p), lane = tid & 63, wave = tid >> 6, r = lane & 31, h = lane >> 5;
    const int hd = bh & 7, bb = bh >> 3;
    bf16_t* sw = (bf16_t*)smem; bf16_t* sqd = sw + 64 * 136; bf16_t* skdt = sqd + 64 * 136; bf16_t* sa = skdt + 128 * 72;
    const bf16_t* wg = (const bf16_t*)(p.ws + WS_W) + (size_t)bh * 128 * 8192;
    const bf16_t* qdg = (const bf16_t*)(p.ws + WS_QD) + (size_t)bh * 128 * 8192;
    const bf16_t* kdtg = (const bf16_t*)(p.ws + WS_KDT) + (size_t)bh * 128 * 8192;
    const bf16_t* ag = (const bf16_t*)(p.ws + WS_A) + (size_t)bh * 128 * 4096;
    const bf16_t* utg = (const bf16_t*)(p.ws + WS_UT) + (size_t)bh * 128 * 8192 + (wave * 32 + r) * 64 + 4 * h;
    const float* glg = (const float*)(p.ws + WS_GLAST) + bh * 128;
    bf16_t* og = (bf16_t*)(p.ws + WS_MIXED) + ((size_t)bb * SEQ_) * LDK + 1024 + hd * 128 + wave * 32 + r;
    __builtin_amdgcn_s_setprio(2);
    f32x16 S[4];
#pragma unroll
    for (int t = 0; t < 4; ++t) zero_acc(S[t]);
    u32x4 pw[4], pq[4], pk[4], pa2[2];
    u32x2 ur[2][4];
#define SC_LOAD(n)                                                                                                   \
    {                                                                                                                \
        _Pragma("unroll") for (int i = 0; i < 4; ++i) { const int c = tid + 256 * i;                                   \
            pw[i] = *(const u32x4*)(wg + (size_t)(n) * 8192 + c * 8); pq[i] = *(const u32x4*)(qdg + (size_t)(n) * 8192 + c * 8); \
            pk[i] = *(const u32x4*)(kdtg + (size_t)(n) * 8192 + c * 8); }                                            \
        _Pragma("unroll") for (int i = 0; i < 2; ++i) { const int c = tid + 256 * i; pa2[i] = *(const u32x4*)(ag + (size_t)(n) * 4096 + c * 8); } \
    }
#define UR_LOAD(n)                                                                                                   \
    {                                                                                                                \
        _Pragma("unroll") for (int ct = 0; ct < 2; ++ct) _Pragma("unroll") for (int g = 0; g < 4; ++g)                \
            ur[ct][g] = *(const u32x2*)(utg + (size_t)(n) * 8192 + ct * 32 + 8 * g);                                 \
    }
    SC_LOAD(0); UR_LOAD(0);
    float gl = glg[0];
    __syncthreads();
    for (int n = 0; n < 128; ++n) {
#pragma unroll
        for (int i = 0; i < 4; ++i) {
            const int c = tid + 256 * i;
            *(u32x4*)(sw + (c >> 4) * 136 + (c & 15) * 8) = pw[i];
            *(u32x4*)(sqd + (c >> 4) * 136 + (c & 15) * 8) = pq[i];
            *(u32x4*)(skdt + (c >> 3) * 72 + (c & 7) * 8) = pk[i];
        }
#pragma unroll
        for (int i = 0; i < 2; ++i) { const int c = tid + 256 * i; *(u32x4*)(sa + (c >> 3) * 72 + (c & 7) * 8) = pa2[i]; }
        __syncthreads();
        const int nn = n + 1 < 128 ? n + 1 : 127;
        SC_LOAD(nn);
        __builtin_amdgcn_sched_barrier(0);
        bf16x8 vf[2][2];
#pragma unroll
        for (int ct = 0; ct < 2; ++ct) {
            f32x16 ws; zero_acc(ws);
#pragma unroll
            for (int t = 0; t < 4; ++t) {
                bf16x8 sf[2]; sf[0] = pack8<0>(S[t]); sf[1] = pack8<1>(S[t]);
#pragma unroll
                for (int s = 0; s < 2; ++s) ws = MFMA(ld_frag_perm(sw + (ct * 32 + r) * 136 + 32 * t + 16 * s + 4 * h), sf[s], ws);
            }
#pragma unroll
            for (int g = 0; g < 4; ++g) {
                ws[4 * g] = bflo(ur[ct][g].x) - ws[4 * g]; ws[4 * g + 1] = bfhi(ur[ct][g].x) - ws[4 * g + 1];
                ws[4 * g + 2] = bflo(ur[ct][g].y) - ws[4 * g + 2]; ws[4 * g + 3] = bfhi(ur[ct][g].y) - ws[4 * g + 3];
            }
            vf[ct][0] = pack8<0>(ws); vf[ct][1] = pack8<1>(ws);
        }
        __builtin_amdgcn_sched_barrier(0);
        UR_LOAD(nn);
#pragma unroll
        for (int cr = 0; cr < 2; ++cr) {
            f32x16 o; zero_acc(o);
#pragma unroll
            for (int t = 0; t < 4; ++t) {
                bf16x8 sf[2]; sf[0] = pack8<0>(S[t]); sf[1] = pack8<1>(S[t]);
#pragma unroll
                for (int s = 0; s < 2; ++s) o = MFMA(ld_frag_perm(sqd + (cr * 32 + r) * 136 + 32 * t + 16 * s + 4 * h), sf[s], o);
            }
#pragma unroll
            for (int ct = 0; ct <= cr; ++ct)
#pragma unroll
                for (int s = 0; s < 2; ++s) o = MFMA(ld_frag_perm(sa + (cr * 32 + r) * 72 + ct * 32 + 16 * s + 4 * h), vf[ct][s], o);
#pragma unroll
            for (int e = 0; e < 16; ++e) og[(size_t)(n * 64 + cr * 32 + crow(e, h)) * LDK] = f2bf(o[e]);
        }
        __builtin_amdgcn_sched_barrier(0);
#pragma unroll
        for (int t = 0; t < 4; ++t) {
#pragma unroll
            for (int e = 0; e < 16; ++e) S[t][e] *= gl;
#pragma unroll
            for (int ct = 0; ct < 2; ++ct)
#pragma unroll
                for (int s = 0; s < 2; ++s) S[t] = MFMA(ld_frag_perm(skdt + (32 * t + r) * 72 + ct * 32 + 16 * s + 4 * h), vf[ct][s], S[t]);
        }
        gl = glg[nn];
        __syncthreads();
    }
#undef SC_LOAD
#undef UR_LOAD
    __builtin_amdgcn_s_setprio(0);
}

DI void phase_norm(const Params& p) {
    const int tid = fresh_tid(p), lane = tid & 63, wave = tid >> 6;
    const bf16_t* pa = (const bf16_t*)(p.ws + WS_PA); bf16_t* mixed = (bf16_t*)(p.ws + WS_MIXED);
    const int col = lane * 16;
    f32x4 gn[4];
#pragma unroll
    for (int i = 0; i < 4; ++i) gn[i] = *(const f32x4*)(p.out_gain + (col & 127) + 4 * i);
    for (int row = p.vb * 4 + wave; row < T_; row += p.vg * 4) {
        bf16_t* mp = mixed + (size_t)row * LDK + 1024 + col;
        const bf16_t* gp = pa + (size_t)row * LDPA + C_GG + col;
        const u32x4 a0 = *(const u32x4*)mp, a1 = *(const u32x4*)(mp + 8);
        const u32x4 g0 = *(const u32x4*)gp, g1 = *(const u32x4*)(gp + 8);
        float v[16] = {bflo(a0.x), bfhi(a0.x), bflo(a0.y), bfhi(a0.y), bflo(a0.z), bfhi(a0.z), bflo(a0.w), bfhi(a0.w),
                       bflo(a1.x), bfhi(a1.x), bflo(a1.y), bfhi(a1.y), bflo(a1.z), bfhi(a1.z), bflo(a1.w), bfhi(a1.w)};
        const float gt[16] = {bflo(g0.x), bfhi(g0.x), bflo(g0.y), bfhi(g0.y), bflo(g0.z), bfhi(g0.z), bflo(g0.w), bfhi(g0.w),
                              bflo(g1.x), bfhi(g1.x), bflo(g1.y), bfhi(g1.y), bflo(g1.z), bfhi(g1.z), bflo(g1.w), bfhi(g1.w)};
        float ss = 0.f;
#pragma unroll
        for (int i = 0; i < 16; ++i) ss += v[i] * v[i];
        ss += __shfl_xor(ss, 1); ss += __shfl_xor(ss, 2); ss += __shfl_xor(ss, 4);
        const float rs = rsqrtf(ss * (1.f / 128.f) + EPS);
#pragma unroll
        for (int i = 0; i < 16; ++i) v[i] = v[i] * rs * gn[i >> 2][i & 3] * silu_f(gt[i]);
        u32x4 o0, o1;
        o0.x = pk2(v[0], v[1]); o0.y = pk2(v[2], v[3]); o0.z = pk2(v[4], v[5]); o0.w = pk2(v[6], v[7]);
        o1.x = pk2(v[8], v[9]); o1.y = pk2(v[10], v[11]); o1.z = pk2(v[12], v[13]); o1.w = pk2(v[14], v[15]);
        *(u32x4*)mp = o0; *(u32x4*)(mp + 8) = o1;
    }
}

DI void attn_item(const Params& p, int bh, int qb, unsigned char* smem) {
    const int tid = fresh_tid(p), lane = tid & 63, wave = tid >> 6, r = lane & 31, h = lane >> 5;
    const int hd = bh & 7, bb = bh >> 3;
    constexpr int KST = 32 * 200, VST = 128 * 40, STG = KST + VST;
    bf16_t* sbase = (bf16_t*)smem;
    const int qrow = qb * 128 + wave * 32 + r;
    const bf16_t* Qg = (const bf16_t*)(p.ws + WS_Q) + ((size_t)bh * SEQ_ + qrow) * 192;
    const bf16_t* Kg = (const bf16_t*)(p.ws + WS_K) + (size_t)bh * SEQ_ * 192;
    const bf16_t* Vg = (const bf16_t*)(p.ws + WS_VT) + (size_t)bh * 128 * SEQ_;
    bf16x8 qf[12];
#pragma unroll
    for (int ks = 0; ks < 12; ++ks) qf[ks] = *(const bf16x8*)(Qg + ks * 16 + h * 8);
    f32x16 O[4];
#pragma unroll
    for (int t = 0; t < 4; ++t) zero_acc(O[t]);
    float m_run = -INFINITY, l_run = 0.f;
    const int ntiles = 4 * qb + 4;
    const int wrow0 = qb * 128 + wave * 32;
    u32x4 rk[3], rv[2];
#define KV_LOAD(jt)                                                                                                    \
    {                                                                                                                  \
        _Pragma("unroll") for (int i = 0; i < 3; ++i) { const int c = tid + 256 * i, row = c / 24, kc = c % 24;          \
            rk[i] = *(const u32x4*)(Kg + (size_t)((jt) * 32 + row) * 192 + kc * 8); }                                  \
        _Pragma("unroll") for (int i = 0; i < 2; ++i) { const int c = tid + 256 * i, row = c >> 2, kc = c & 3;           \
            rv[i] = *(const u32x4*)(Vg + (size_t)row * SEQ_ + (jt) * 32 + kc * 8); }                                   \
    }
#define KV_STORE(buf)                                                                                                  \
    {                                                                                                                  \
        bf16_t* sk_ = sbase + (buf) * STG; bf16_t* sv_ = sk_ + KST;                                                    \
        _Pragma("unroll") for (int i = 0; i < 3; ++i) { const int c = tid + 256 * i, row = c / 24, kc = c % 24;          \
            *(u32x4*)(sk_ + row * 200 + kc * 8) = rk[i]; }                                                             \
        _Pragma("unroll") for (int i = 0; i < 2; ++i) { const int c = tid + 256 * i, row = c >> 2, kc = c & 3;           \
            *(u32x4*)(sv_ + row * 40 + kc * 8) = rv[i]; }                                                              \
    }
    KV_LOAD(0);
    __syncthreads();
    KV_STORE(0);
    if (ntiles > 1) KV_LOAD(1);
    __syncthreads();
    for (int jt = 0; jt < ntiles; ++jt) {
        if (jt + 1 < ntiles) KV_STORE((jt + 1) & 1);
        if (jt + 2 < ntiles) KV_LOAD(jt + 2);
        const int key0 = jt * 32;
        if (key0 <= wrow0) {
            const bf16_t* sK = sbase + (jt & 1) * STG; const bf16_t* sV = sK + KST;
            f32x16 sc; zero_acc(sc);
            {
                bf16x8 kf[12];
#pragma unroll
                for (int ks = 0; ks < 12; ++ks) kf[ks] = *(const bf16x8*)(sK + r * 200 + ks * 16 + h * 8);
#pragma unroll
                for (int ks = 0; ks < 12; ++ks) sc = MFMA(kf[ks], qf[ks], sc);
                __builtin_amdgcn_sched_group_barrier(0x100, 6, 0);
#pragma unroll
                for (int q = 0; q < 6; ++q) { __builtin_amdgcn_sched_group_barrier(0x008, 1, 0); __builtin_amdgcn_sched_group_barrier(0x100, 1, 0); }
                __builtin_amdgcn_sched_group_barrier(0x008, 6, 0);
            }
            if (key0 == wrow0) {
#pragma unroll
                for (int e = 0; e < 16; ++e) if (key0 + crow(e, h) > qrow) sc[e] = -INFINITY;
            }
            if (jt == 0) {
                float mx = sc[0];
#pragma unroll
                for (int e = 1; e < 16; ++e) mx = fmaxf(mx, sc[e]);
                m_run = fmaxf(mx, __shfl_xor(mx, 32));
            }
            float ls = 0.f;
#pragma unroll
            for (int e = 0; e < 16; ++e) { const float pv = __builtin_amdgcn_exp2f(sc[e] - m_run); sc[e] = pv; ls += pv; }
            l_run += ls;
            bf16x8 pf[2]; pf[0] = pack8<0>(sc); pf[1] = pack8<1>(sc);
            {
                bf16x8 vfr[2][4];
#pragma unroll
                for (int s = 0; s < 2; ++s)
#pragma unroll
                    for (int t = 0; t < 4; ++t) vfr[s][t] = ld_frag_perm(sV + (t * 32 + r) * 40 + 16 * s + 4 * h);
#pragma unroll
                for (int s = 0; s < 2; ++s)
#pragma unroll
                    for (int t = 0; t < 4; ++t) O[t] = MFMA(vfr[s][t], pf[s], O[t]);
                __builtin_amdgcn_sched_group_barrier(0x100, 8, 0);
#pragma unroll
                for (int q = 0; q < 4; ++q) { __builtin_amdgcn_sched_group_barrier(0x008, 1, 0); __builtin_amdgcn_sched_group_barrier(0x100, 2, 0); }
                __builtin_amdgcn_sched_group_barrier(0x008, 4, 0);
            }
        }
        __syncthreads();
    }
#undef KV_LOAD
#undef KV_STORE
    l_run += __shfl_xor(l_run, 32);
    const float inv = 1.f / l_run;
    const size_t tok = (size_t)bb * SEQ_ + qrow;
    const bf16_t* gp = (const bf16_t*)(p.ws + WS_PA) + tok * LDPA + C_MG + hd * 128;
    bf16_t* mp = (bf16_t*)(p.ws + WS_MIXED) + tok * LDK + hd * 128;
#pragma unroll
    for (int t = 0; t < 4; ++t)
#pragma unroll
        for (int g = 0; g < 4; ++g) {
            const int dv = t * 32 + 8 * g + 4 * h;
            const u32x2 gt = *(const u32x2*)(gp + dv);
            u32x2 ov;
            ov.x = pk2(O[t][4 * g] * inv * silu_f(bflo(gt.x)), O[t][4 * g + 1] * inv * silu_f(bfhi(gt.x)));
            ov.y = pk2(O[t][4 * g + 2] * inv * silu_f(bflo(gt.y)), O[t][4 * g + 3] * inv * silu_f(bfhi(gt.y)));
            *(u32x2*)(mp + dv) = ov;
        }
}

DI void phase3(const Params& p, unsigned char* smem, int* s_item) {
    unsigned* ctr = (unsigned*)(p.ws + WS_CTRL);
    if (p.vb < 64) {
        if ((p.vb & 1) == 0) scan_item(p, p.vb >> 1, smem);
        else { __syncthreads(); for (int n = 0; n < 128; ++n) { __syncthreads(); __syncthreads(); } }
    }
    for (;;) {
        if ((p.vb & 1) == 0 && fresh_tid(p) == 0) *s_item = (int)atomicAdd(ctr, 1u);
        __syncthreads();
        const int pair = *s_item;
        __syncthreads();
        if (pair >= 1024) break;
        const int item = pair * 2 + (p.vb & 1);
        attn_item(p, item & 31, 63 - (item >> 5), smem);
    }
}

DI void phase4(const Params& p, unsigned char* smem) {
    const bf16_t* mixed = (const bf16_t*)(p.ws + WS_MIXED);
    const bf16_t* wt = (const bf16_t*)(p.ws + WS_WOUT);
    for_tiles3(T_ / 256, 2048 / 256, [&](int mt, int nt) {
        const int lane = fresh_tid(p) & 63, fr = lane & 15, fq = lane >> 4, wm = p.wave8 >> 2, wn = p.wave8 & 3;
        f32x4 acc[8][4];
        gemm3_mainloop(p.wave8, lane, mixed + (size_t)mt * 256 * LDK, LDK, wt + (size_t)nt * 256 * LDK, LDK, 2048, smem, acc);
#pragma unroll
        for (int i = 0; i < 8; ++i) {
            const size_t m = (size_t)mt * 256 + wm * 128 + i * 16 + fr;
#pragma unroll
            for (int j = 0; j < 4; ++j) {
                const int c = nt * 256 + wn * 64 + j * 16 + fq * 4;
                const f32x4 xv = __builtin_nontemporal_load((const f32x4*)(p.x + m * DM + c));
                *(f32x4*)(p.out + m * DM + c) = xv + acc[i][j];
            }
        }
    });
}

__global__ void __launch_bounds__(512, 2) hymba_fwd(Params pin) {
    extern __shared__ __attribute__((aligned(16))) unsigned char smem[];
    Params p = pin;
    p.wave8 = __builtin_amdgcn_readfirstlane((int)(threadIdx.x >> 6));
    p.wave_u = p.wave8 & 3;
    const int half = p.wave8 >> 2;
    p.vb = blockIdx.x * 2 + half; p.vg = gridDim.x * 2;
    unsigned char* smem_h = smem + half * HALF_LDS;
    int* s_item = (int*)(smem + 2 * HALF_LDS);
    phase0(p, smem_h);
    cg::this_grid().sync();
    phase1(p, smem);
    grid_barrier(p, 1);
    phase2(p, smem_h);
    grid_barrier(p, 2);
    phase3(p, smem_h, s_item);
    grid_barrier(p, 3);
    phase_norm(p);
    grid_barrier(p, 4);
    phase4(p, smem);
}

extern "C" void kernel_launch(void* const* d_in, const int* in_sizes, int n_in, void* d_out, int out_size, void* d_ws, size_t ws_size,
                              hipStream_t stream) {
    static int grid_blocks = 0;
    if (grid_blocks == 0) {
        if (n_in != 15 || ws_size < WS_END) { fprintf(stderr, "kernel_launch: unexpected n_in %d or ws_size %zu (< %zu)\n", n_in, ws_size, (size_t)WS_END); grid_blocks = -1; return; }
        int dev = 0, cus = 0, per_cu = 0;
        (void)hipGetDevice(&dev);
        (void)hipDeviceGetAttribute(&cus, hipDeviceAttributeMultiprocessorCount, dev);
        (void)hipFuncSetAttribute((const void*)hymba_fwd, hipFuncAttributeMaxDynamicSharedMemorySize, SMEM_BYTES);
        (void)hipOccupancyMaxActiveBlocksPerMultiprocessor(&per_cu, (const void*)hymba_fwd, 512, SMEM_BYTES);
        grid_blocks = cus;
        grid_blocks -= grid_blocks % 8;
    }
    if (grid_blocks < 0) return;
    Params p{};
    p.x = (const float*)d_in[0]; p.pos = (const int*)d_in[1]; p.norm_gain = (const float*)d_in[2]; p.w_in = (const float*)d_in[3];
    p.q_a_gain = (const float*)d_in[4]; p.kv_a_gain = (const float*)d_in[5]; p.w_uq = (const float*)d_in[6]; p.w_ukv = (const float*)d_in[7];
    p.q_gain = (const float*)d_in[8]; p.k_gain = (const float*)d_in[9]; p.conv_w = (const float*)d_in[10]; p.a_log = (const float*)d_in[11];
    p.dt_bias = (const float*)d_in[12]; p.out_gain = (const float*)d_in[13]; p.w_out = (const float*)d_in[14];
    p.out = (float*)d_out; p.ws = (unsigned char*)d_ws;
    void* args[] = {&p};
    hipError_t e = hipLaunchCooperativeKernel((const void*)hymba_fwd, dim3(grid_blocks), dim3(512), args, SMEM_BYTES, stream);
    if (e != hipSuccess) fprintf(stderr, "cooperative launch failed: %s (grid %d)\n", hipGetErrorString(e), grid_blocks);
}
```

```cpp
#include <hip/hip_runtime.h>
#include <hip/hip_cooperative_groups.h>
#include <cstdio>
#include <cstdint>
namespace cg = cooperative_groups;

#ifndef MULTI_LAUNCH
#define MULTI_LAUNCH 0
#endif

typedef unsigned short bf16_t;
typedef short bf16x8 __attribute__((ext_vector_type(8)));
typedef float f32x16 __attribute__((ext_vector_type(16)));
typedef float f32x4 __attribute__((ext_vector_type(4)));
typedef unsigned u32x4 __attribute__((ext_vector_type(4)));
typedef unsigned u32x2 __attribute__((ext_vector_type(2)));
typedef __bf16 bf2_t __attribute__((ext_vector_type(2)));
typedef float f2_t __attribute__((ext_vector_type(2)));

#define DI __device__ __forceinline__
#define MFMA(a, b, c) __builtin_amdgcn_mfma_f32_32x32x16_bf16((a), (b), (c), 0, 0, 0)

constexpr int T_ = 32768;
constexpr int SEQ_ = 8192;
constexpr int DM = 2048;
constexpr int LDK = 2112;
constexpr int NPAD = 6144;
constexpr int LDPA = 2944;
constexpr int LDPB = 3072;
constexpr int C_KR = 768, C_GAB = 832, C_MG = 896, C_GG = 1920;
constexpr float EPS = 1e-6f;
constexpr float QSCALE = 0.07216878364870323f * 1.4426950408889634f;

constexpr size_t WS_CTRL = 0;
constexpr size_t WS_SSQ = 4096;
constexpr size_t WS_GAB = WS_SSQ + 2 * 131072;
constexpr size_t WS_GLAST = WS_GAB + (size_t)T_ * 16 * 4;
constexpr size_t WS_WIN = WS_GLAST + 16384;
constexpr size_t WS_WUQ = WS_WIN + (size_t)NPAD * LDK * 2;
constexpr size_t WS_WUKV = WS_WUQ + (size_t)1536 * 512 * 2;
constexpr size_t WS_WOUT = WS_WUKV + (size_t)2048 * 256 * 2;
constexpr size_t WS_PA = WS_WOUT + (size_t)2048 * LDK * 2;
constexpr size_t WS_PB = WS_PA + (size_t)T_ * LDPA * 2;
constexpr size_t WS_XN = WS_PB + (size_t)T_ * LDPB * 2;
constexpr size_t WS_Q = WS_XN + (size_t)T_ * LDK * 2;
constexpr size_t WS_K = WS_Q + (size_t)T_ * 8 * 192 * 2;
constexpr size_t WS_VT = WS_K + (size_t)T_ * 8 * 192 * 2;
constexpr size_t WS_QD = WS_VT + (size_t)T_ * 1024 * 2;
constexpr size_t WS_KDT = WS_QD + (size_t)T_ * 1024 * 2;
constexpr size_t WS_A = WS_KDT + (size_t)T_ * 1024 * 2;
constexpr size_t WS_END = WS_A + (size_t)4096 * 4096 * 2;
constexpr size_t WS_MIXED = WS_PB;
constexpr size_t WS_UT = WS_XN;
constexpr size_t WS_W = WS_XN + (size_t)T_ * 1024 * 2;

constexpr int SMEM_MAIN = 73728;
constexpr int HALF_LDS = SMEM_MAIN + 128;
constexpr int SMEM_BYTES = 2 * HALF_LDS + 64;

struct Params {
    const float* x; const int* pos; const float* norm_gain; const float* w_in; const float* q_a_gain; const float* kv_a_gain;
    const float* w_uq; const float* w_ukv; const float* q_gain; const float* k_gain; const float* conv_w; const float* a_log;
    const float* dt_bias; const float* out_gain; const float* w_out; float* out; unsigned char* ws;
    int wave_u;
    int vb, vg;
    int wave8;
};

DI unsigned pk2(float a, float b) { f2_t v = {a, b}; bf2_t r = __builtin_convertvector(v, bf2_t); return __builtin_bit_cast(unsigned, r); }
DI bf16_t f2bf(float a) { return (bf16_t)(pk2(a, 0.f) & 0xffffu); }
DI float bflo(unsigned u) { return __uint_as_float(u << 16); }
DI float bfhi(unsigned u) { return __uint_as_float(u & 0xffff0000u); }
DI float bf2f(bf16_t v) { return __uint_as_float(((unsigned)v) << 16); }
DI int crow(int e, int h) { return (e & 3) + 8 * (e >> 2) + 4 * h; }
DI float wave_sum(float v) {
#pragma unroll
    for (int o = 1; o < 64; o <<= 1) v += __shfl_xor(v, o);
    return v;
}
template <int S> DI bf16x8 pack8(const f32x16& x) {
    u32x4 p;
    p.x = pk2(x[8 * S + 0], x[8 * S + 1]); p.y = pk2(x[8 * S + 2], x[8 * S + 3]);
    p.z = pk2(x[8 * S + 4], x[8 * S + 5]); p.w = pk2(x[8 * S + 6], x[8 * S + 7]);
    return __builtin_bit_cast(bf16x8, p);
}
DI bf16x8 ld_frag_perm(const bf16_t* p) {
    u32x2 lo = *(const u32x2*)p; u32x2 hi = *(const u32x2*)(p + 8);
    u32x4 v = {lo.x, lo.y, hi.x, hi.y};
    return __builtin_bit_cast(bf16x8, v);
}
DI int fresh_tid(const Params& p) { int t = p.wave_u * 64 + (int)__builtin_amdgcn_mbcnt_hi(~0u, __builtin_amdgcn_mbcnt_lo(~0u, 0u)); asm volatile("" : "+v"(t)); return t; }
DI unsigned gb_ld(unsigned* q) { return __hip_atomic_load(q, __ATOMIC_RELAXED, __HIP_MEMORY_SCOPE_AGENT); }
DI unsigned gb_add(unsigned* q, unsigned v) { return __hip_atomic_fetch_add(q, v, __ATOMIC_RELAXED, __HIP_MEMORY_SCOPE_AGENT); }
DI void grid_barrier(const Params& p, unsigned round  ) {
    asm volatile("s_waitcnt vmcnt(0)" ::: "memory");
    __syncthreads();
    if (p.wave8 == 0 && (fresh_tid(p) & 63) == 0) {
        unsigned* bar = (unsigned*)(p.ws + WS_CTRL);
        __builtin_amdgcn_fence(__ATOMIC_RELEASE, "agent");
        asm volatile("s_waitcnt vmcnt(0)" ::: "memory");
        const unsigned g = blockIdx.x & 7, nloc = gridDim.x >> 3;
        const unsigned old = gb_add(bar + 128 + g * 32, 1u);
        if (old + 1u == round * nloc) {
            const unsigned og = gb_add(bar + 512, 1u);
            if (og + 1u == round * 8u) gb_add(bar + 640, 1u);
        }
        while (gb_ld(bar + 640) < round) __builtin_amdgcn_s_sleep(1);
        __builtin_amdgcn_fence(__ATOMIC_ACQUIRE, "agent");
        asm volatile("s_waitcnt vmcnt(0)" ::: "memory");
    }
    __syncthreads();
}
DI float silu_f(float y) { return y / (1.f + __expf(-y)); }
DI void zero_acc(f32x16& a) {
#pragma unroll
    for (int e = 0; e < 16; ++e) a[e] = 0.f;
}

DI int win_src_col(int n) {
    if (n < 832) return n;
    if (n < 848) return 4928 + (n - 832);
    if (n < 896) return -1;
    if (n < 1920) return 832 + (n - 896);
    if (n < 2944) return 4944 + (n - 1920);
    if (n < 6016) return 1856 + (n - 2944);
    return -1;
}
template <int MODE>
DI void transpose_tile(const float* __restrict__ W, int K, int Nsrc, bf16_t* __restrict__ WT, int ldo, const float* __restrict__ gain, int k0, int n0,
                       unsigned char* smem, int tid) {
    bf16_t* t = (bf16_t*)smem;
#pragma unroll 4
    for (int i = 0; i < 16; ++i) {
        const int e = tid + 256 * i, kk = e >> 6, nn = e & 63;
        const int src = MODE == 0 ? win_src_col(n0 + nn) : (n0 + nn);
        float v = src >= 0 ? W[(size_t)(k0 + kk) * Nsrc + src] : 0.f;
        if (gain) v *= gain[k0 + kk];
        t[nn * 66 + kk] = f2bf(v);
    }
    __syncthreads();
#pragma unroll
    for (int i = 0; i < 2; ++i) {
        const int c = tid + 256 * i, nn = c >> 3, kc = c & 7;
        const unsigned* s = (const unsigned*)(t + nn * 66 + kc * 8);
        u32x4 o = {s[0], s[1], s[2], s[3]};
        *(u32x4*)(WT + (size_t)(n0 + nn) * ldo + k0 + kc * 8) = o;
    }
    __syncthreads();
}

DI void phase0(const Params& p, unsigned char* smem) {
    const int tid = fresh_tid(p), b = p.vb, G = p.vg;
    float* ssq = (float*)(p.ws + WS_SSQ);
    for (int i = b * 256 + tid; i < 65536; i += G * 256) ssq[i] = 0.f;
    if (b == 0) { for (int i = tid; i < 1024; i += 256) if (i < 64 || i >= 96) ((unsigned*)(p.ws + WS_CTRL))[i] = 0u; }
    if (b == 1 && tid < 32) ((float*)(p.ws + WS_CTRL + 256))[tid] = powf(10000.f, -(float)tid / 32.f);
    constexpr int T_IN = 32 * 96, T_UQ = 8 * 24, T_UKV = 4 * 32, T_OUT = 32 * 32;
    for (int it = b; it < T_IN + T_UQ + T_UKV + T_OUT; it += G) {
        int r = it; const int tid = fresh_tid(p);
        if (r < T_IN) { transpose_tile<0>(p.w_in, 2048, 5968, (bf16_t*)(p.ws + WS_WIN), LDK, nullptr, (r / 96) * 64, (r % 96) * 64, smem, tid); continue; }
        r -= T_IN;
        if (r < T_UQ) { transpose_tile<1>(p.w_uq, 512, 1536, (bf16_t*)(p.ws + WS_WUQ), 512, p.q_a_gain, (r / 24) * 64, (r % 24) * 64, smem, tid); continue; }
        r -= T_UQ;
        if (r < T_UKV) { transpose_tile<1>(p.w_ukv, 256, 2048, (bf16_t*)(p.ws + WS_WUKV), 256, p.kv_a_gain, (r / 32) * 64, (r % 32) * 64, smem, tid); continue; }
        r -= T_UKV;
        transpose_tile<1>(p.w_out, 2048, 2048, (bf16_t*)(p.ws + WS_WOUT), LDK, nullptr, (r / 32) * 64, (r % 32) * 64, smem, tid);
    }
    const int lane = tid & 63, wave = tid >> 6;
    bf16_t* xn = (bf16_t*)(p.ws + WS_XN);
    for (int row = b * 4 + wave; row < T_; row += G * 8) {
        const int row2 = row + G * 4;
        const f32x4* xr = (const f32x4*)(p.x + (size_t)row * DM);
        const f32x4* xr2 = (const f32x4*)(p.x + (size_t)row2 * DM);
        f32x4 v[8], w[8]; float ss = 0.f, ss2 = 0.f;
#pragma unroll
        for (int i = 0; i < 8; ++i) { v[i] = xr[lane + 64 * i]; w[i] = xr2[lane + 64 * i]; }
#pragma unroll
        for (int i = 0; i < 8; ++i) {
            ss += v[i].x * v[i].x + v[i].y * v[i].y + v[i].z * v[i].z + v[i].w * v[i].w;
            ss2 += w[i].x * w[i].x + w[i].y * w[i].y + w[i].z * w[i].z + w[i].w * w[i].w;
        }
        ss = wave_sum(ss); ss2 = wave_sum(ss2);
        const float rs = rsqrtf(ss * (1.f / DM) + EPS), rs2 = rsqrtf(ss2 * (1.f / DM) + EPS);
#pragma unroll
        for (int i = 0; i < 8; ++i) {
            const f32x4 g = ((const f32x4*)p.norm_gain)[lane + 64 * i];
            u32x2 o; o.x = pk2(v[i].x * rs * g.x, v[i].y * rs * g.y); o.y = pk2(v[i].z * rs * g.z, v[i].w * rs * g.w);
            *(u32x2*)(xn + (size_t)row * LDK + (lane + 64 * i) * 4) = o;
            u32x2 o2; o2.x = pk2(w[i].x * rs2 * g.x, w[i].y * rs2 * g.y); o2.y = pk2(w[i].z * rs2 * g.z, w[i].w * rs2 * g.w);
            *(u32x2*)(xn + (size_t)row2 * LDK + (lane + 64 * i) * 4) = o2;
        }
    }
}

template <int BM, int BN, int BK, int WAVES_M, int WAVES_N, int UNSWAP_FROM>
DI void gemm_mainloop(const int tid, const bf16_t* __restrict__ A, int lda, const bf16_t* __restrict__ Bt, int ldb, int K, unsigned char* smem,
                      f32x16 (&acc)[BM / WAVES_M / 32][BN / WAVES_N / 32]) {
    constexpr int WM = BM / WAVES_M / 32, WN = BN / WAVES_N / 32;
    constexpr int LS = BK + 8;
    constexpr int A_ST = BM * LS * 2, B_ST = BN * LS * 2, STAGE = A_ST + B_ST;
    constexpr int CPR = BK / 8, NA = BM * CPR / 256, NB = BN * CPR / 256;
    static_assert(2 * STAGE <= SMEM_MAIN, "LDS");
    const int lane = tid & 63, wave = tid >> 6, r = lane & 31, h = lane >> 5;
    const int wm = wave / WAVES_N, wn = wave % WAVES_N;
    u32x4 ra[NA], rb[NB];
#pragma unroll
    for (int i = 0; i < WM; ++i)
#pragma unroll
        for (int j = 0; j < WN; ++j) zero_acc(acc[i][j]);
    const int nk = K / BK;
#define G_LOAD(kt)                                                                                              \
    {                                                                                                           \
        _Pragma("unroll") for (int i = 0; i < NA; ++i) { const int c = tid + 256 * i, row = c / CPR, kc = c % CPR; \
            ra[i] = *(const u32x4*)(A + (size_t)row * lda + (kt) * BK + kc * 8); }                              \
        _Pragma("unroll") for (int i = 0; i < NB; ++i) { const int c = tid + 256 * i, row = c / CPR, kc = c % CPR; \
            rb[i] = *(const u32x4*)(Bt + (size_t)row * ldb + (kt) * BK + kc * 8); }                             \
    }
#define G_STORE(buf)                                                                                            \
    {                                                                                                           \
        unsigned char* sa_ = smem + (buf) * STAGE; unsigned char* sb_ = sa_ + A_ST;                             \
        _Pragma("unroll") for (int i = 0; i < NA; ++i) { const int c = tid + 256 * i, row = c / CPR, kc = c % CPR; \
            *(u32x4*)(sa_ + (row * LS + kc * 8) * 2) = ra[i]; }                                                 \
        _Pragma("unroll") for (int i = 0; i < NB; ++i) { const int c = tid + 256 * i, row = c / CPR, kc = c % CPR; \
            *(u32x4*)(sb_ + (row * LS + kc * 8) * 2) = rb[i]; }                                                 \
    }
    G_LOAD(0); G_STORE(0); __syncthreads();
    for (int kt = 0; kt < nk; ++kt) {
        const int buf = kt & 1;
        if (kt + 1 < nk) G_LOAD(kt + 1);
        const unsigned char* sa_ = smem + buf * STAGE; const unsigned char* sb_ = sa_ + A_ST;
#pragma unroll
        for (int ks = 0; ks < BK / 16; ++ks) {
            bf16x8 af[WM], bfr[WN];
#pragma unroll
            for (int i = 0; i < WM; ++i) af[i] = *(const bf16x8*)(sa_ + (((wm * WM + i) * 32 + r) * LS + ks * 16 + h * 8) * 2);
#pragma unroll
            for (int j = 0; j < WN; ++j) bfr[j] = *(const bf16x8*)(sb_ + (((wn * WN + j) * 32 + r) * LS + ks * 16 + h * 8) * 2);
#pragma unroll
            for (int i = 0; i < WM; ++i)
#pragma unroll
                for (int j = 0; j < WN; ++j) {
                    if (j < UNSWAP_FROM) acc[i][j] = MFMA(bfr[j], af[i], acc[i][j]);
                    else acc[i][j] = MFMA(af[i], bfr[j], acc[i][j]);
                }
        }
        if (kt + 1 < nk) G_STORE(buf ^ 1);
        __syncthreads();
    }
#undef G_LOAD
#undef G_STORE
}

typedef __attribute__((address_space(3))) unsigned lds_u32;
#define MFMA16(a, b, c) __builtin_amdgcn_mfma_f32_16x16x32_bf16((a), (b), (c), 0, 0, 0)
DI void gemm3_mainloop(const int wave8, const int lane, const bf16_t* __restrict__ A, int lda, const bf16_t* __restrict__ Bt, int ldb, int K,
                       unsigned char* smem, f32x4 (&acc)[8][4]) {
    constexpr int STAGE = 512 * 128, B_OFF = 256 * 128;
    const int fr = lane & 15, fq = lane >> 4, wm = wave8 >> 2, wn = wave8 & 3;
    const int t512 = wave8 * 64 + lane;
#pragma unroll
    for (int i = 0; i < 8; ++i)
#pragma unroll
        for (int j = 0; j < 4; ++j) acc[i][j] = (f32x4){0.f, 0.f, 0.f, 0.f};
    const int nk = K / 64;
    const int srow = t512 >> 3, ssc = (t512 & 7) ^ ((srow >> 1) & 7);
    const bf16_t* ga = A + (size_t)srow * lda + ssc * 8;
    const bf16_t* gb = Bt + (size_t)srow * ldb + ssc * 8;
    unsigned char* sdst = smem + wave8 * 1024;
#define G3_LDA(buf, kt, i) __builtin_amdgcn_global_load_lds((const unsigned*)(ga + (size_t)((i) * 64) * lda + (kt) * 64), (lds_u32*)(sdst + (buf) * STAGE + (i) * 8192), 16, 0, 0)
#define G3_LDB(buf, kt, i) __builtin_amdgcn_global_load_lds((const unsigned*)(gb + (size_t)((i) * 64) * ldb + (kt) * 64), (lds_u32*)(sdst + (buf) * STAGE + B_OFF + (i) * 8192), 16, 0, 0)
    const int sw = (fr >> 1) & 7;
#define G3_HALF(buf, nbuf, kn, hf)                                                                               \
    {                                                                                                            \
        const unsigned char* sa_ = smem + (buf) * STAGE; const unsigned char* sb_ = sa_ + B_OFF;                 \
        const int co = (((hf) * 4 + fq) ^ sw) * 16;                                                              \
        bf16x8 af[8], bfr[4];                                                                                    \
        _Pragma("unroll") for (int j = 0; j < 4; ++j) bfr[j] = *(const bf16x8*)(sb_ + (wn * 64 + j * 16 + fr) * 128 + co); \
        _Pragma("unroll") for (int i = 0; i < 8; ++i) af[i] = *(const bf16x8*)(sa_ + (wm * 128 + i * 16 + fr) * 128 + co); \
        _Pragma("unroll") for (int i = 0; i < 8; ++i) {                                                            \
            _Pragma("unroll") for (int j = 0; j < 4; ++j) acc[i][j] = MFMA16(bfr[j], af[i], acc[i][j]);            \
            if (i < 4) { if ((hf) == 0) { G3_LDA(nbuf, kn, i); } else { G3_LDB(nbuf, kn, i); } }                  \
        }                                                                                                        \
        __builtin_amdgcn_sched_group_barrier(0x100, 12, 0);                                                      \
        _Pragma("unroll") for (int q = 0; q < 4; ++q) { __builtin_amdgcn_sched_group_barrier(0x008, 4, 0); __builtin_amdgcn_sched_group_barrier(0x020, 1, 0); } \
        __builtin_amdgcn_sched_group_barrier(0x008, 16, 0);                                                      \
    }
#define G3_STEP(buf, nbuf, kt)                                                                                   \
    {                                                                                                            \
        const int kn_ = ((kt) + 1 < nk) ? (kt) + 1 : (kt);         \
        G3_HALF(buf, nbuf, kn_, 0); G3_HALF(buf, nbuf, kn_, 1);                                                   \
        asm volatile("s_waitcnt vmcnt(0)" ::: "memory");                                                         \
        __builtin_amdgcn_s_barrier();                                                                            \
    }
    asm volatile("s_waitcnt vmcnt(0)" ::: "memory");
    G3_LDA(0, 0, 0); G3_LDA(0, 0, 1); G3_LDA(0, 0, 2); G3_LDA(0, 0, 3); G3_LDB(0, 0, 0); G3_LDB(0, 0, 1); G3_LDB(0, 0, 2); G3_LDB(0, 0, 3);
    asm volatile("s_waitcnt vmcnt(0)" ::: "memory");
    __builtin_amdgcn_s_barrier();
    for (int kt = 0; kt < nk; kt += 2) { G3_STEP(0, 1, kt); G3_STEP(1, 0, kt + 1); }
#undef G3_STEP
#undef G3_HALF
#undef G3_LDA
#undef G3_LDB
}

template <typename F> DI void for_tiles3(int MT, int NT, F f) {
    const int b = blockIdx.x, G = gridDim.x, xcd = b & 7, slot = b >> 3, slots = G >> 3;
    const int nsn = NT / 4, nsm = MT / 8;
    for (int sidx = xcd; sidx < nsn * nsm; sidx += 8) {
        const int sm = sidx / nsn, sn = sidx % nsn;
        for (int tl = slot; tl < 32; tl += slots) f(sm * 8 + (tl & 7), sn * 4 + (tl >> 3));
    }
}

DI void phase1(const Params& p, unsigned char* smem) {
    const bf16_t* xn = (const bf16_t*)(p.ws + WS_XN);
    const bf16_t* wt = (const bf16_t*)(p.ws + WS_WIN);
    bf16_t* pa = (bf16_t*)(p.ws + WS_PA); bf16_t* pb = (bf16_t*)(p.ws + WS_PB);
    float* ssq = (float*)(p.ws + WS_SSQ); float* gab = (float*)(p.ws + WS_GAB);
    for_tiles3(T_ / 256, NPAD / 256, [&](int mt, int nt) {
        const int lane = fresh_tid(p) & 63, fr = lane & 15, fq = lane >> 4, wm = p.wave8 >> 2, wn = p.wave8 & 3;
        f32x4 acc[8][4];
        gemm3_mainloop(p.wave8, lane, xn + (size_t)mt * 256 * LDK, LDK, wt + (size_t)nt * 256 * LDK, LDK, DM, smem, acc);
        const int c128 = nt * 2 + (wn >> 1);
        if (c128 >= 47) return;
        bf16_t* dst; int ld, c0;
        if (c128 < 23) { dst = pa; ld = LDPA; c0 = c128 * 128; } else { dst = pb; ld = LDPB; c0 = (c128 - 23) * 128; }
#pragma unroll
        for (int i = 0; i < 8; ++i) {
            const int m = mt * 256 + wm * 128 + i * 16 + fr;
            float ss = 0.f;
#pragma unroll
            for (int j = 0; j < 4; ++j) {
                const f32x4 v = acc[i][j];
                ss += v.x * v.x + v.y * v.y + v.z * v.z + v.w * v.w;
                u32x2 o; o.x = pk2(v.x, v.y); o.y = pk2(v.z, v.w);
                *(u32x2*)(dst + (size_t)m * ld + c0 + (wn & 1) * 64 + j * 16 + fq * 4) = o;
            }
            if (c128 < 6) {
                ss += __shfl_xor(ss, 16); ss += __shfl_xor(ss, 32);
                if (fq == 0) atomicAdd(ssq + (c128 < 4 ? 0 : T_) + m, ss);
            }
            if (c128 == 6 && (wn & 1) == 1) *(f32x4*)(gab + (size_t)m * 16 + fq * 4) = acc[i][0];
        }
    });
}

DI void sincos_rev(float ang, float& sn, float& cs) {
    const float c_hi = 0.15915494309189535f, c_lo = -6.0e-9f * 0.0f + (float)(0.15915494309189535 - (double)0.15915494309189535f);
    const float pr = ang * c_hi, er = __builtin_fmaf(ang, c_hi, -pr);
    const float rev = __builtin_amdgcn_fractf(pr) + (er + ang * c_lo);
    sn = __builtin_amdgcn_sinf(rev); cs = __builtin_amdgcn_cosf(rev);
}

DI void q_tile(const Params& p, int mt, int hd, unsigned char* smem) {
    const bf16_t* pa = (const bf16_t*)(p.ws + WS_PA);
    const bf16_t* wt = (const bf16_t*)(p.ws + WS_WUQ);
    const float* ssq = (const float*)(p.ws + WS_SSQ);
    bf16_t* Q = (bf16_t*)(p.ws + WS_Q);
    const int tid = fresh_tid(p), lane = tid & 63, wave = tid >> 6, r = lane & 31, h = lane >> 5;
    f32x16 acc[1][6];
    gemm_mainloop<128, 192, 32, 4, 1, 99>(tid, pa + (size_t)mt * 128 * LDPA, LDPA, wt + (size_t)hd * 192 * 512, 512, 512, smem, acc);
    const int m = mt * 128 + wave * 32 + r;
    const float rq = rsqrtf(ssq[m] * (1.f / 512.f) + EPS);
    float ss = 0.f;
#pragma unroll
    for (int j = 0; j < 6; ++j)
#pragma unroll
        for (int e = 0; e < 16; ++e) { const float v = acc[0][j][e] * rq; acc[0][j][e] = v; ss += v * v; }
    ss += __shfl_xor(ss, 32);
    const float rs = rsqrtf(ss * (1.f / 192.f) + EPS) * QSCALE;
    const int bb = m >> 13, s = m & 8191;
    bf16_t* qrow = Q + ((size_t)(bb * 8 + hd) * SEQ_ + s) * 192;
#pragma unroll
    for (int j = 0; j < 4; ++j)
#pragma unroll
        for (int g = 0; g < 4; ++g) {
            const int n = j * 32 + 8 * g + 4 * h;
            const f32x4 gn = *(const f32x4*)(p.q_gain + n);
            u32x2 o; o.x = pk2(acc[0][j][4 * g] * rs * gn.x, acc[0][j][4 * g + 1] * rs * gn.y);
            o.y = pk2(acc[0][j][4 * g + 2] * rs * gn.z, acc[0][j][4 * g + 3] * rs * gn.w);
            *(u32x2*)(qrow + n) = o;
        }
    const float posf = (float)p.pos[m];
    const float* invf = (const float*)(p.ws + WS_CTRL + 256);
#pragma unroll
    for (int g = 0; g < 4; ++g) {
        float o1[4], o2[4];
#pragma unroll
        for (int jj = 0; jj < 4; ++jj) {
            const int i = 8 * g + 4 * h + jj;
            float sn, cs; sincos_rev(posf * invf[i], sn, cs);
            const float x1 = acc[0][4][4 * g + jj] * rs * p.q_gain[128 + i], x2 = acc[0][5][4 * g + jj] * rs * p.q_gain[160 + i];
            o1[jj] = x1 * cs - x2 * sn; o2[jj] = x2 * cs + x1 * sn;
        }
        u32x2 a; a.x = pk2(o1[0], o1[1]); a.y = pk2(o1[2], o1[3]);
        u32x2 c; c.x = pk2(o2[0], o2[1]); c.y = pk2(o2[2], o2[3]);
        *(u32x2*)(qrow + 128 + 8 * g + 4 * h) = a;
        *(u32x2*)(qrow + 160 + 8 * g + 4 * h) = c;
    }
}

DI void kv_tile(const Params& p, int mt, int hd, unsigned char* smem) {
    const bf16_t* pa = (const bf16_t*)(p.ws + WS_PA);
    const bf16_t* wt = (const bf16_t*)(p.ws + WS_WUKV);
    const float* ssq = (const float*)(p.ws + WS_SSQ) + T_;
    bf16_t* Kb = (bf16_t*)(p.ws + WS_K); bf16_t* Vt = (bf16_t*)(p.ws + WS_VT);
    const int tid = fresh_tid(p), lane = tid & 63, wave = tid >> 6, r = lane & 31, h = lane >> 5;
    f32x16 acc[1][4];
    const int mw = mt * 128 + wave * 32;
    const int bb = mw >> 13, sw = mw & 8191, bh = bb * 8 + hd;
    gemm_mainloop<128, 128, 32, 4, 1, 0>(tid, pa + (size_t)mt * 128 * LDPA + 512, LDPA, wt + (size_t)(hd * 256 + 128) * 256, 256, 256, smem, acc);
#pragma unroll
    for (int g = 0; g < 4; ++g) {
        const f32x4 q4 = *(const f32x4*)(ssq + mw + 8 * g + 4 * h);
        const float r0 = rsqrtf(q4.x * (1.f / 256.f) + EPS), r1 = rsqrtf(q4.y * (1.f / 256.f) + EPS);
        const float r2 = rsqrtf(q4.z * (1.f / 256.f) + EPS), r3 = rsqrtf(q4.w * (1.f / 256.f) + EPS);
#pragma unroll
        for (int j = 0; j < 4; ++j) {
            u32x2 o; o.x = pk2(acc[0][j][4 * g] * r0, acc[0][j][4 * g + 1] * r1); o.y = pk2(acc[0][j][4 * g + 2] * r2, acc[0][j][4 * g + 3] * r3);
            *(u32x2*)(Vt + ((size_t)bh * 128 + j * 32 + r) * SEQ_ + sw + 8 * g + 4 * h) = o;
        }
    }
    gemm_mainloop<128, 128, 32, 4, 1, 99>(tid, pa + (size_t)mt * 128 * LDPA + 512, LDPA, wt + (size_t)(hd * 256) * 256, 256, 256, smem, acc);
    const int m = mw + r, s = sw + r;
    const float rkv = rsqrtf(ssq[m] * (1.f / 256.f) + EPS);
    float ss = 0.f;
#pragma unroll
    for (int j = 0; j < 4; ++j)
#pragma unroll
        for (int e = 0; e < 16; ++e) { const float v = acc[0][j][e] * rkv; acc[0][j][e] = v; ss += v * v; }
    float x1[16], x2[16];
#pragma unroll
    for (int g = 0; g < 4; ++g) {
        const u32x2 a = *(const u32x2*)(pa + (size_t)m * LDPA + C_KR + 8 * g + 4 * h);
        const u32x2 c = *(const u32x2*)(pa + (size_t)m * LDPA + C_KR + 32 + 8 * g + 4 * h);
        x1[4 * g] = bflo(a.x); x1[4 * g + 1] = bfhi(a.x); x1[4 * g + 2] = bflo(a.y); x1[4 * g + 3] = bfhi(a.y);
        x2[4 * g] = bflo(c.x); x2[4 * g + 1] = bfhi(c.x); x2[4 * g + 2] = bflo(c.y); x2[4 * g + 3] = bfhi(c.y);
    }
#pragma unroll
    for (int e = 0; e < 16; ++e) ss += x1[e] * x1[e] + x2[e] * x2[e];
    ss += __shfl_xor(ss, 32);
    const float rs = rsqrtf(ss * (1.f / 192.f) + EPS);
    bf16_t* krow = Kb + ((size_t)bh * SEQ_ + s) * 192;
#pragma unroll
    for (int j = 0; j < 4; ++j)
#pragma unroll
        for (int g = 0; g < 4; ++g) {
            const int n = j * 32 + 8 * g + 4 * h;
            const f32x4 gn = *(const f32x4*)(p.k_gain + n);
            u32x2 o; o.x = pk2(acc[0][j][4 * g] * rs * gn.x, acc[0][j][4 * g + 1] * rs * gn.y);
            o.y = pk2(acc[0][j][4 * g + 2] * rs * gn.z, acc[0][j][4 * g + 3] * rs * gn.w);
            *(u32x2*)(krow + n) = o;
        }
    const float posf = (float)p.pos[m];
    const float* invf = (const float*)(p.ws + WS_CTRL + 256);
#pragma unroll
    for (int g = 0; g < 4; ++g) {
        float o1[4], o2[4];
#pragma unroll
        for (int jj = 0; jj < 4; ++jj) {
            const int i = 8 * g + 4 * h + jj;
            float sn, cs; sincos_rev(posf * invf[i], sn, cs);
            const float y1 = x1[4 * g + jj] * rs * p.k_gain[128 + i], y2 = x2[4 * g + jj] * rs * p.k_gain[160 + i];
            o1[jj] = y1 * cs - y2 * sn; o2[jj] = y2 * cs + y1 * sn;
        }
        u32x2 a; a.x = pk2(o1[0], o1[1]); a.y = pk2(o1[2], o1[3]);
        u32x2 c; c.x = pk2(o2[0], o2[1]); c.y = pk2(o2[2], o2[3]);
        *(u32x2*)(krow + 128 + 8 * g + 4 * h) = a;
        *(u32x2*)(krow + 160 + 8 * g + 4 * h) = c;
    }
}

DI void gdn_prep(const Params& p, int item, unsigned char* smem) {
    const int tid = fresh_tid(p), lane = tid & 63, wave = tid >> 6, r = lane & 31, h = lane >> 5;
    const int bb = item >> 10, hd = (item >> 7) & 7, n = item & 127;
    const int tok0 = bb * SEQ_ + n * 64;
    const bf16_t* pb = (const bf16_t*)(p.ws + WS_PB);
    const float* gab = (const float*)(p.ws + WS_GAB);
    bf16_t* sq = (bf16_t*)smem; bf16_t* sk = sq + 64 * 136; bf16_t* sv = sk + 64 * 136;
    float* sL = (float*)(smem + 52224);
    float* sgc = (float*)(smem + 69632); float* sbeta = sgc + 64; float* segc = sbeta + 64;
    {
        const int dch = lane & 15, sub = lane >> 4, t0 = wave * 16 + sub * 4;
#pragma unroll
        for (int X = 0; X < 3; ++X) {
            const int col = X * 1024 + hd * 128 + dch * 8;
            float xr[7][8];
#pragma unroll
            for (int rr = 0; rr < 7; ++rr) {
                const int t = t0 - 3 + rr;
                u32x4 v = {0u, 0u, 0u, 0u};
                if (n > 0 || t >= 0) v = *(const u32x4*)(pb + (size_t)(tok0 + t) * LDPB + col);
                xr[rr][0] = bflo(v.x); xr[rr][1] = bfhi(v.x); xr[rr][2] = bflo(v.y); xr[rr][3] = bfhi(v.y);
                xr[rr][4] = bflo(v.z); xr[rr][5] = bfhi(v.z); xr[rr][6] = bflo(v.w); xr[rr][7] = bfhi(v.w);
            }
            float y[4][8];
#pragma unroll
            for (int tt = 0; tt < 4; ++tt)
#pragma unroll
                for (int c = 0; c < 8; ++c) y[tt][c] = 0.f;
#pragma unroll
            for (int j = 0; j < 4; ++j) {
                const f32x4 w0 = *(const f32x4*)(p.conv_w + j * 3072 + col), w1 = *(const f32x4*)(p.conv_w + j * 3072 + col + 4);
                const float wv[8] = {w0.x, w0.y, w0.z, w0.w, w1.x, w1.y, w1.z, w1.w};
#pragma unroll
                for (int tt = 0; tt < 4; ++tt)
#pragma unroll
                    for (int c = 0; c < 8; ++c) y[tt][c] += xr[tt + j][c] * wv[c];
            }
#pragma unroll
            for (int tt = 0; tt < 4; ++tt) {
                float ss = 0.f;
#pragma unroll
                for (int c = 0; c < 8; ++c) { y[tt][c] = silu_f(y[tt][c]); ss += y[tt][c] * y[tt][c]; }
                float sc = 1.f;
                if (X < 2) {
                    ss += __shfl_xor(ss, 1); ss += __shfl_xor(ss, 2); ss += __shfl_xor(ss, 4); ss += __shfl_xor(ss, 8);
                    sc = rsqrtf(ss + EPS) * (X == 0 ? 0.08838834764831845f : 1.f);
                }
                u32x4 o; o.x = pk2(y[tt][0] * sc, y[tt][1] * sc); o.y = pk2(y[tt][2] * sc, y[tt][3] * sc);
                o.z = pk2(y[tt][4] * sc, y[tt][5] * sc); o.w = pk2(y[tt][6] * sc, y[tt][7] * sc);
                bf16_t* dstp = (X == 0 ? sq : (X == 1 ? sk : sv)) + (t0 + tt) * 136 + dch * 8;
                *(u32x4*)dstp = o;
            }
        }
    }
    if (wave == 0) {
        const float ga = gab[(size_t)(tok0 + lane) * 16 + hd], gb = gab[(size_t)(tok0 + lane) * 16 + 8 + hd];
        const float xx = ga + p.dt_bias[hd];
        const float sp = xx > 20.f ? xx : log1pf(expf(xx));
        float g = -expf(p.a_log[hd]) * sp;
#pragma unroll
        for (int o = 1; o < 64; o <<= 1) { const float t = __shfl_up(g, o); if (lane >= o) g += t; }
        sgc[lane] = g; segc[lane] = expf(g); sbeta[lane] = 1.f / (1.f + expf(-gb));
    }
    __syncthreads();
    {
        const int ti = wave >> 1, tj = wave & 1;
        f32x16 akk, aqk; zero_acc(akk); zero_acc(aqk);
        if (ti >= tj) {
#pragma unroll
            for (int ks = 0; ks < 8; ++ks) {
                const bf16x8 ak = *(const bf16x8*)(sk + (ti * 32 + r) * 136 + ks * 16 + h * 8);
                const bf16x8 aq = *(const bf16x8*)(sq + (ti * 32 + r) * 136 + ks * 16 + h * 8);
                const bf16x8 bk = *(const bf16x8*)(sk + (tj * 32 + r) * 136 + ks * 16 + h * 8);
                akk = MFMA(ak, bk, akk); aqk = MFMA(aq, bk, aqk);
            }
        }
        bf16_t* ag = (bf16_t*)(p.ws + WS_A) + (size_t)item * 4096;
        const int j = tj * 32 + r; const float gcj = sgc[j];
#pragma unroll
        for (int e = 0; e < 16; ++e) {
            const int c = ti * 32 + crow(e, h);
            const float dec = c >= j ? expf(sgc[c] - gcj) : 0.f;
            sL[c * 68 + j] = c > j ? sbeta[c] * akk[e] * dec : 0.f;
            ag[c * 64 + j] = f2bf(aqk[e] * dec);
        }
    }
    __syncthreads();
    {
        float X[64];
        const bf16_t* src = tid < 128 ? (sv + tid) : (sk + tid - 128);
#pragma unroll
        for (int i = 0; i < 64; ++i) { float a = bf2f(src[i * 136]) * sbeta[i]; if (tid >= 128) a *= segc[i]; X[i] = a; }
#pragma unroll
        for (int i = 1; i < 64; ++i) {
            float a = X[i];
            int dep; asm volatile("v_and_b32 %0, 0, %1" : "=v"(dep) : "v"(X[i - 1]));
            const float* Lr = sL + i * 68 + dep;
            float b0 = 0.f, b1 = 0.f, b2 = 0.f;
#pragma unroll
            for (int j4 = 0; j4 < (i + 3) / 4; ++j4) {
                const f32x4 l = *(const f32x4*)(Lr + 4 * j4);
                if (4 * j4 + 0 < i) a -= l.x * X[4 * j4 + 0];
                if (4 * j4 + 1 < i) b0 -= l.y * X[4 * j4 + 1];
                if (4 * j4 + 2 < i) b1 -= l.z * X[4 * j4 + 2];
                if (4 * j4 + 3 < i) b2 -= l.w * X[4 * j4 + 3];
            }
            X[i] = (a + b0) + (b1 + b2);
        }
        if (tid < 128) {
            bf16_t* ut = (bf16_t*)(p.ws + WS_UT) + (size_t)item * 8192 + tid * 64;
#pragma unroll
            for (int c8 = 0; c8 < 8; ++c8) {
                u32x4 o; o.x = pk2(X[8 * c8], X[8 * c8 + 1]); o.y = pk2(X[8 * c8 + 2], X[8 * c8 + 3]);
                o.z = pk2(X[8 * c8 + 4], X[8 * c8 + 5]); o.w = pk2(X[8 * c8 + 6], X[8 * c8 + 7]);
                *(u32x4*)(ut + c8 * 8) = o;
            }
        } else {
            bf16_t* wg = (bf16_t*)(p.ws + WS_W) + (size_t)item * 8192 + (tid - 128);
#pragma unroll
            for (int i = 0; i < 64; ++i) wg[i * 128] = f2bf(X[i]);
        }
    }
    {
        bf16_t* qd = (bf16_t*)(p.ws + WS_QD) + (size_t)item * 8192;
        const int c = tid >> 2, d0 = (tid & 3) * 32; const float eg = segc[c];
#pragma unroll
        for (int q4 = 0; q4 < 4; ++q4) {
            const u32x4 v = *(const u32x4*)(sq + c * 136 + d0 + q4 * 8);
            u32x4 o; o.x = pk2(bflo(v.x) * eg, bfhi(v.x) * eg); o.y = pk2(bflo(v.y) * eg, bfhi(v.y) * eg);
            o.z = pk2(bflo(v.z) * eg, bfhi(v.z) * eg); o.w = pk2(bflo(v.w) * eg, bfhi(v.w) * eg);
            *(u32x4*)(qd + c * 128 + d0 + q4 * 8) = o;
        }
        bf16_t* kdt = (bf16_t*)(p.ws + WS_KDT) + (size_t)item * 8192;
        const int d = tid & 127, ch = tid >> 7; const float gl = sgc[63];
#pragma unroll
        for (int c8 = 0; c8 < 4; ++c8) {
            float v[8];
#pragma unroll
            for (int e = 0; e < 8; ++e) { const int cc = ch * 32 + c8 * 8 + e; v[e] = bf2f(sk[cc * 136 + d]) * expf(gl - sgc[cc]); }
            u32x4 o; o.x = pk2(v[0], v[1]); o.y = pk2(v[2], v[3]); o.z = pk2(v[4], v[5]); o.w = pk2(v[6], v[7]);
            *(u32x4*)(kdt + d * 64 + ch * 32 + c8 * 8) = o;
        }
        if (tid == 0) ((float*)(p.ws + WS_GLAST))[item] = expf(gl);
    }
    __syncthreads();
}

DI void phase2(const Params& p, unsigned char* smem) {
    for (int it = p.vb; it < 8192; it += p.vg) {
        if (it < 4096) gdn_prep(p, it, smem);
        else if (it < 6144) { const int r = it - 4096; q_tile(p, r >> 3, r & 7, smem); }
        else { const int r = it - 6144; kv_tile(p, r >> 3, r & 7, smem); }
    }
}

DI void scan_item(const Params& p, int bh, unsigned char* smem) {
    const int tid = fresh_tid(p), lane = tid & 63, wave = tid >> 6, r = lane & 31, h = lane >> 5;
    const int hd = bh & 7, bb = bh >> 3;
    bf16_t* sw = (bf16_t*)smem; bf16_t* sqd = sw + 64 * 136; bf16_t* skdt = sqd + 64 * 136; bf16_t* sa = skdt + 128 * 72;
    const bf16_t* wg = (const bf16_t*)(p.ws + WS_W) + (size_t)bh * 128 * 8192;
    const bf16_t* qdg = (const bf16_t*)(p.ws + WS_QD) + (size_t)bh * 128 * 8192;
    const bf16_t* kdtg = (const bf16_t*)(p.ws + WS_KDT) + (size_t)bh * 128 * 8192;
    const bf16_t* ag = (const bf16_t*)(p.ws + WS_A) + (size_t)bh * 128 * 4096;
    const bf16_t* utg = (const bf16_t*)(p.ws + WS_UT) + (size_t)bh * 128 * 8192 + (wave * 32 + r) * 64 + 4 * h;
    const float* glg = (const float*)(p.ws + WS_GLAST) + bh * 128;
    bf16_t* og = (bf16_t*)(p.ws + WS_MIXED) + ((size_t)bb * SEQ_) * LDK + 1024 + hd * 128 + wave * 32 + r;
    __builtin_amdgcn_s_setprio(2);
    f32x16 S[4];
#pragma unroll
    for (int t = 0; t < 4; ++t) zero_acc(S[t]);
    u32x4 pw[4], pq[4], pk[4], pa2[2];
    u32x2 ur[2][4];
#define SC_LOAD(n)                                                                                                   \
    {                                                                                                                \
        _Pragma("unroll") for (int i = 0; i < 4; ++i) { const int c = tid + 256 * i;                                   \
            pw[i] = *(const u32x4*)(wg + (size_t)(n) * 8192 + c * 8); pq[i] = *(const u32x4*)(qdg + (size_t)(n) * 8192 + c * 8); \
            pk[i] = *(const u32x4*)(kdtg + (size_t)(n) * 8192 + c * 8); }                                            \
        _Pragma("unroll") for (int i = 0; i < 2; ++i) { const int c = tid + 256 * i; pa2[i] = *(const u32x4*)(ag + (size_t)(n) * 4096 + c * 8); } \
    }
#define UR_LOAD(n)                                                                                                   \
    {                                                                                                                \
        _Pragma("unroll") for (int ct = 0; ct < 2; ++ct) _Pragma("unroll") for (int g = 0; g < 4; ++g)                \
            ur[ct][g] = *(const u32x2*)(utg + (size_t)(n) * 8192 + ct * 32 + 8 * g);                                 \
    }
    SC_LOAD(0); UR_LOAD(0);
    float gl = glg[0];
    __syncthreads();
    for (int n = 0; n < 128; ++n) {
#pragma unroll
        for (int i = 0; i < 4; ++i) {
            const int c = tid + 256 * i;
            *(u32x4*)(sw + (c >> 4) * 136 + (c & 15) * 8) = pw[i];
            *(u32x4*)(sqd + (c >> 4) * 136 + (c & 15) * 8) = pq[i];
            *(u32x4*)(skdt + (c >> 3) * 72 + (c & 7) * 8) = pk[i];
        }
#pragma unroll
        for (int i = 0; i < 2; ++i) { const int c = tid + 256 * i; *(u32x4*)(sa + (c >> 3) * 72 + (c & 7) * 8) = pa2[i]; }
        __syncthreads();
        const int nn = n + 1 < 128 ? n + 1 : 127;
        SC_LOAD(nn);
        __builtin_amdgcn_sched_barrier(0);
        bf16x8 vf[2][2];
#pragma unroll
        for (int ct = 0; ct < 2; ++ct) {
            f32x16 ws; zero_acc(ws);
#pragma unroll
            for (int t = 0; t < 4; ++t) {
                bf16x8 sf[2]; sf[0] = pack8<0>(S[t]); sf[1] = pack8<1>(S[t]);
#pragma unroll
                for (int s = 0; s < 2; ++s) ws = MFMA(ld_frag_perm(sw + (ct * 32 + r) * 136 + 32 * t + 16 * s + 4 * h), sf[s], ws);
            }
#pragma unroll
            for (int g = 0; g < 4; ++g) {
                ws[4 * g] = bflo(ur[ct][g].x) - ws[4 * g]; ws[4 * g + 1] = bfhi(ur[ct][g].x) - ws[4 * g + 1];
                ws[4 * g + 2] = bflo(ur[ct][g].y) - ws[4 * g + 2]; ws[4 * g + 3] = bfhi(ur[ct][g].y) - ws[4 * g + 3];
            }
            vf[ct][0] = pack8<0>(ws); vf[ct][1] = pack8<1>(ws);
        }
        __builtin_amdgcn_sched_barrier(0);
        UR_LOAD(nn);
#pragma unroll
        for (int cr = 0; cr < 2; ++cr) {
            f32x16 o; zero_acc(o);
#pragma unroll
            for (int t = 0; t < 4; ++t) {
                bf16x8 sf[2]; sf[0] = pack8<0>(S[t]); sf[1] = pack8<1>(S[t]);
#pragma unroll
                for (int s = 0; s < 2; ++s) o = MFMA(ld_frag_perm(sqd + (cr * 32 + r) * 136 + 32 * t + 16 * s + 4 * h), sf[s], o);
            }
#pragma unroll
            for (int ct = 0; ct <= cr; ++ct)
#pragma unroll
                for (int s = 0; s < 2; ++s) o = MFMA(ld_frag_perm(sa + (cr * 32 + r) * 72 + ct * 32 + 16 * s + 4 * h), vf[ct][s], o);
#pragma unroll
            for (int e = 0; e < 16; ++e) og[(size_t)(n * 64 + cr * 32 + crow(e, h)) * LDK] = f2bf(o[e]);
        }
        __builtin_amdgcn_sched_barrier(0);
#pragma unroll
        for (int t = 0; t < 4; ++t) {
#pragma unroll
            for (int e = 0; e < 16; ++e) S[t][e] *= gl;
#pragma unroll
            for (int ct = 0; ct < 2; ++ct)
#pragma unroll
                for (int s = 0; s < 2; ++s) S[t] = MFMA(ld_frag_perm(skdt + (32 * t + r) * 72 + ct * 32 + 16 * s + 4 * h), vf[ct][s], S[t]);
        }
        gl = glg[nn];
        __syncthreads();
    }
#undef SC_LOAD
#undef UR_LOAD
    __builtin_amdgcn_s_setprio(0);
}

DI void phase_norm(const Params& p) {
    const int tid = fresh_tid(p), lane = tid & 63, wave = tid >> 6;
    const bf16_t* pa = (const bf16_t*)(p.ws + WS_PA); bf16_t* mixed = (bf16_t*)(p.ws + WS_MIXED);
    const int col = lane * 16;
    f32x4 gn[4];
#pragma unroll
    for (int i = 0; i < 4; ++i) gn[i] = *(const f32x4*)(p.out_gain + (col & 127) + 4 * i);
    for (int row = p.vb * 4 + wave; row < T_; row += p.vg * 4) {
        bf16_t* mp = mixed + (size_t)row * LDK + 1024 + col;
        const bf16_t* gp = pa + (size_t)row * LDPA + C_GG + col;
        const u32x4 a0 = *(const u32x4*)mp, a1 = *(const u32x4*)(mp + 8);
        const u32x4 g0 = *(const u32x4*)gp, g1 = *(const u32x4*)(gp + 8);
        float v[16] = {bflo(a0.x), bfhi(a0.x), bflo(a0.y), bfhi(a0.y), bflo(a0.z), bfhi(a0.z), bflo(a0.w), bfhi(a0.w),
                       bflo(a1.x), bfhi(a1.x), bflo(a1.y), bfhi(a1.y), bflo(a1.z), bfhi(a1.z), bflo(a1.w), bfhi(a1.w)};
        const float gt[16] = {bflo(g0.x), bfhi(g0.x), bflo(g0.y), bfhi(g0.y), bflo(g0.z), bfhi(g0.z), bflo(g0.w), bfhi(g0.w),
                              bflo(g1.x), bfhi(g1.x), bflo(g1.y), bfhi(g1.y), bflo(g1.z), bfhi(g1.z), bflo(g1.w), bfhi(g1.w)};
        float ss = 0.f;
#pragma unroll
        for (int i = 0; i < 16; ++i) ss += v[i] * v[i];
        ss += __shfl_xor(ss, 1); ss += __shfl_xor(ss, 2); ss += __shfl_xor(ss, 4);
        const float rs = rsqrtf(ss * (1.f / 128.f) + EPS);
#pragma unroll
        for (int i = 0; i < 16; ++i) v[i] = v[i] * rs * gn[i >> 2][i & 3] * silu_f(gt[i]);
        u32x4 o0, o1;
        o0.x = pk2(v[0], v[1]); o0.y = pk2(v[2], v[3]); o0.z = pk2(v[4], v[5]); o0.w = pk2(v[6], v[7]);
        o1.x = pk2(v[8], v[9]); o1.y = pk2(v[10], v[11]); o1.z = pk2(v[12], v[13]); o1.w = pk2(v[14], v[15]);
        *(u32x4*)mp = o0; *(u32x4*)(mp + 8) = o1;
    }
}

DI void attn_item(const Params& p, int bh, int qb, unsigned char* smem) {
    const int lane = fresh_tid(p) & 63, wave = p.wave8, tid = wave * 64 + lane, r = lane & 31, h = lane >> 5;
    const int hd = bh & 7, bb = bh >> 3;
    constexpr int KST = 32 * 200, VST = 128 * 40, STG = KST + VST;
    bf16_t* sbase = (bf16_t*)smem;
    const int qrow = qb * 256 + wave * 32 + r;
    const bf16_t* Qg = (const bf16_t*)(p.ws + WS_Q) + ((size_t)bh * SEQ_ + qrow) * 192;
    const bf16_t* Kg = (const bf16_t*)(p.ws + WS_K) + (size_t)bh * SEQ_ * 192;
    const bf16_t* Vg = (const bf16_t*)(p.ws + WS_VT) + (size_t)bh * 128 * SEQ_;
    bf16x8 qf[12];
#pragma unroll
    for (int ks = 0; ks < 12; ++ks) qf[ks] = *(const bf16x8*)(Qg + ks * 16 + h * 8);
    f32x16 O[4];
#pragma unroll
    for (int t = 0; t < 4; ++t) zero_acc(O[t]);
    float m_run = -INFINITY, l_run = 0.f;
    const int ntiles = 8 * qb + 8;
    const int wrow0 = qb * 256 + wave * 32;
    const bool lo = wave < 4;
    u32x4 rk[2], rv[1];
#define KV_LOAD(jt)                                                                                                    \
    {                                                                                                                  \
        { const int c = tid, row = c / 24, kc = c % 24; rk[0] = *(const u32x4*)(Kg + (size_t)((jt) * 32 + row) * 192 + kc * 8); } \
        if (lo) { const int c = tid + 512, row = c / 24, kc = c % 24; rk[1] = *(const u32x4*)(Kg + (size_t)((jt) * 32 + row) * 192 + kc * 8); } \
        { const int row = tid >> 2, kc = tid & 3; rv[0] = *(const u32x4*)(Vg + (size_t)row * SEQ_ + (jt) * 32 + kc * 8); } \
    }
#define KV_STORE(buf)                                                                                                  \
    {                                                                                                                  \
        bf16_t* sk_ = sbase + (buf) * STG; bf16_t* sv_ = sk_ + KST;                                                    \
        { const int c = tid, row = c / 24, kc = c % 24; *(u32x4*)(sk_ + row * 200 + kc * 8) = rk[0]; }                 \
        if (lo) { const int c = tid + 512, row = c / 24, kc = c % 24; *(u32x4*)(sk_ + row * 200 + kc * 8) = rk[1]; }   \
        { const int row = tid >> 2, kc = tid & 3; *(u32x4*)(sv_ + row * 40 + kc * 8) = rv[0]; }                        \
    }
    KV_LOAD(0);
    __syncthreads();
    KV_STORE(0);
    if (ntiles > 1) KV_LOAD(1);
    __syncthreads();
    for (int jt = 0; jt < ntiles; ++jt) {
        if (jt + 1 < ntiles) KV_STORE((jt + 1) & 1);
        if (jt + 2 < ntiles) KV_LOAD(jt + 2);
        const int key0 = jt * 32;
        if (key0 <= wrow0) {
            const bf16_t* sK = sbase + (jt & 1) * STG; const bf16_t* sV = sK + KST;
            f32x16 sc; zero_acc(sc);
            {
                bf16x8 kf[12];
#pragma unroll
                for (int ks = 0; ks < 12; ++ks) kf[ks] = *(const bf16x8*)(sK + r * 200 + ks * 16 + h * 8);
#pragma unroll
                for (int ks = 0; ks < 12; ++ks) sc = MFMA(kf[ks], qf[ks], sc);
                __builtin_amdgcn_sched_group_barrier(0x100, 6, 0);
#pragma unroll
                for (int q = 0; q < 6; ++q) { __builtin_amdgcn_sched_group_barrier(0x008, 1, 0); __builtin_amdgcn_sched_group_barrier(0x100, 1, 0); }
                __builtin_amdgcn_sched_group_barrier(0x008, 6, 0);
            }
            if (key0 == wrow0) {
#pragma unroll
                for (int e = 0; e < 16; ++e) if (key0 + crow(e, h) > qrow) sc[e] = -INFINITY;
            }
            if (jt == 0) {
                float mx = sc[0];
#pragma unroll
                for (int e = 1; e < 16; ++e) mx = fmaxf(mx, sc[e]);
                m_run = fmaxf(mx, __shfl_xor(mx, 32));
            }
            float ls = 0.f;
#pragma unroll
            for (int e = 0; e < 16; ++e) { const float pv = __builtin_amdgcn_exp2f(sc[e] - m_run); sc[e] = pv; ls += pv; }
            l_run += ls;
            bf16x8 pf[2]; pf[0] = pack8<0>(sc); pf[1] = pack8<1>(sc);
            {
                bf16x8 vfr[2][4];
#pragma unroll
                for (int s = 0; s < 2; ++s)
#pragma unroll
                    for (int t = 0; t < 4; ++t) vfr[s][t] = ld_frag_perm(sV + (t * 32 + r) * 40 + 16 * s + 4 * h);
#pragma unroll
                for (int s = 0; s < 2; ++s)
#pragma unroll
                    for (int t = 0; t < 4; ++t) O[t] = MFMA(vfr[s][t], pf[s], O[t]);
                __builtin_amdgcn_sched_group_barrier(0x100, 8, 0);
#pragma unroll
                for (int q = 0; q < 4; ++q) { __builtin_amdgcn_sched_group_barrier(0x008, 1, 0); __builtin_amdgcn_sched_group_barrier(0x100, 2, 0); }
                __builtin_amdgcn_sched_group_barrier(0x008, 4, 0);
            }
        }
        __syncthreads();
    }
#undef KV_LOAD
#undef KV_STORE
    l_run += __shfl_xor(l_run, 32);
    const float inv = 1.f / l_run;
    const size_t tok = (size_t)bb * SEQ_ + qrow;
    const bf16_t* gp = (const bf16_t*)(p.ws + WS_PA) + tok * LDPA + C_MG + hd * 128;
    bf16_t* mp = (bf16_t*)(p.ws + WS_MIXED) + tok * LDK + hd * 128;
#pragma unroll
    for (int t = 0; t < 4; ++t)
#pragma unroll
        for (int g = 0; g < 4; ++g) {
            const int dv = t * 32 + 8 * g + 4 * h;
            const u32x2 gt = *(const u32x2*)(gp + dv);
            u32x2 ov;
            ov.x = pk2(O[t][4 * g] * inv * silu_f(bflo(gt.x)), O[t][4 * g + 1] * inv * silu_f(bfhi(gt.x)));
            ov.y = pk2(O[t][4 * g + 2] * inv * silu_f(bflo(gt.y)), O[t][4 * g + 3] * inv * silu_f(bfhi(gt.y)));
            *(u32x2*)(mp + dv) = ov;
        }
}

DI void phase3(const Params& p, unsigned char* smem, unsigned char* smem_wg, int* s_item) {
    unsigned* ctr = (unsigned*)(p.ws + WS_CTRL);
    if (p.vb < 64) {
        if ((p.vb & 1) == 0) scan_item(p, p.vb >> 1, smem);
        else { __syncthreads(); for (int n = 0; n < 128; ++n) { __syncthreads(); __syncthreads(); } }
    }
    for (;;) {
        if ((p.vb & 1) == 0 && fresh_tid(p) == 0) *s_item = (int)atomicAdd(ctr, 1u);
        __syncthreads();
        const int item = *s_item;
        __syncthreads();
        if (item >= 1024) break;
        attn_item(p, item & 31, 31 - (item >> 5), smem_wg);
    }
}

DI void phase4(const Params& p, unsigned char* smem) {
    const bf16_t* mixed = (const bf16_t*)(p.ws + WS_MIXED);
    const bf16_t* wt = (const bf16_t*)(p.ws + WS_WOUT);
    for_tiles3(T_ / 256, 2048 / 256, [&](int mt, int nt) {
        const int lane = fresh_tid(p) & 63, fr = lane & 15, fq = lane >> 4, wm = p.wave8 >> 2, wn = p.wave8 & 3;
        f32x4 acc[8][4];
        gemm3_mainloop(p.wave8, lane, mixed + (size_t)mt * 256 * LDK, LDK, wt + (size_t)nt * 256 * LDK, LDK, 2048, smem, acc);
#pragma unroll
        for (int i = 0; i < 8; ++i) {
            const size_t m = (size_t)mt * 256 + wm * 128 + i * 16 + fr;
#pragma unroll
            for (int j = 0; j < 4; ++j) {
                const int c = nt * 256 + wn * 64 + j * 16 + fq * 4;
                const f32x4 xv = *(const f32x4*)(p.x + m * DM + c);
                *(f32x4*)(p.out + m * DM + c) = xv + acc[i][j];
            }
        }
    });
}

__global__ void __launch_bounds__(512, 2) hymba_fwd(Params pin) {
    extern __shared__ __attribute__((aligned(16))) unsigned char smem[];
    Params p = pin;
    p.wave8 = __builtin_amdgcn_readfirstlane((int)(threadIdx.x >> 6));
    p.wave_u = p.wave8 & 3;
    const int half = p.wave8 >> 2;
    p.vb = blockIdx.x * 2 + half; p.vg = gridDim.x * 2;
    unsigned char* smem_h = smem + half * HALF_LDS;
    int* s_item = (int*)(smem + 2 * HALF_LDS);
    phase0(p, smem_h);
    cg::this_grid().sync();
    phase1(p, smem);
    grid_barrier(p, 1);
    phase2(p, smem_h);
    grid_barrier(p, 2);
    phase3(p, smem_h, smem, s_item);
    grid_barrier(p, 3);
    phase_norm(p);
    grid_barrier(p, 4);
    phase4(p, smem);
}

extern "C" void kernel_launch(void* const* d_in, const int* in_sizes, int n_in, void* d_out, int out_size, void* d_ws, size_t ws_size,
                              hipStream_t stream) {
    static int grid_blocks = 0;
    if (grid_blocks == 0) {
        if (n_in != 15 || ws_size < WS_END) { fprintf(stderr, "kernel_launch: unexpected n_in %d or ws_size %zu (< %zu)\n", n_in, ws_size, (size_t)WS_END); grid_blocks = -1; return; }
        int dev = 0, cus = 0, per_cu = 0;
        (void)hipGetDevice(&dev);
        (void)hipDeviceGetAttribute(&cus, hipDeviceAttributeMultiprocessorCount, dev);
        (void)hipFuncSetAttribute((const void*)hymba_fwd, hipFuncAttributeMaxDynamicSharedMemorySize, SMEM_BYTES);
        (void)hipOccupancyMaxActiveBlocksPerMultiprocessor(&per_cu, (const void*)hymba_fwd, 512, SMEM_BYTES);
        grid_blocks = cus;
        grid_blocks -= grid_blocks % 8;
    }
    if (grid_blocks < 0) return;
    Params p{};
    p.x = (const float*)d_in[0]; p.pos = (const int*)d_in[1]; p.norm_gain = (const float*)d_in[2]; p.w_in = (const float*)d_in[3];
    p.q_a_gain = (const float*)d_in[4]; p.kv_a_gain = (const float*)d_in[5]; p.w_uq = (const float*)d_in[6]; p.w_ukv = (const float*)d_in[7];
    p.q_gain = (const float*)d_in[8]; p.k_gain = (const float*)d_in[9]; p.conv_w = (const float*)d_in[10]; p.a_log = (const float*)d_in[11];
    p.dt_bias = (const float*)d_in[12]; p.out_gain = (const float*)d_in[13]; p.w_out = (const float*)d_in[14];
    p.out = (float*)d_out; p.ws = (unsigned char*)d_ws;
    void* args[] = {&p};
    hipError_t e = hipLaunchCooperativeKernel((const void*)hymba_fwd, dim3(grid_blocks), dim3(512), args, SMEM_BYTES, stream);
    if (e != hipSuccess) fprintf(stderr, "cooperative launch failed: %s (grid %d)\n", hipGetErrorString(e), grid_blocks);
}
```
